# Optimizing an MI355X kernel written in HIP

```python
import jax, jax.numpy as jnp
from jax import lax
import numpy as np

D_MODEL = 2048
BATCH = 1
SEQ = 16384
DEPTH = 1

N_HEADS = 16
QK_NOPE_DIM = 128
QK_ROPE_DIM = 64
QK_HEAD_DIM = QK_NOPE_DIM + QK_ROPE_DIM
V_HEAD_DIM = 128
Q_LORA_RANK = 512
KV_LORA_RANK = 512
MLA_WIDTH = N_HEADS * V_HEAD_DIM
ROPE_THETA = 10000.0
Q_BLOCK = 128
POOL_WINDOWS = (2, 4, 8, 16)
POOL_GROUPS = len(POOL_WINDOWS)
POOL_GROUP_DIM = 256
POOL_WIDTH = POOL_GROUPS * POOL_GROUP_DIM
N_BRANCHES = 2
RMS_EPS = 1e-6
LN_EPS = 1e-5
DEEPNORM_ALPHA = (2.0 * DEPTH) ** 0.25
DEEPNORM_BETA = (8.0 * DEPTH) ** -0.25

IN_SPLITS = (Q_LORA_RANK, KV_LORA_RANK + QK_ROPE_DIM, MLA_WIDTH, POOL_WIDTH, POOL_WIDTH, N_BRANCHES * D_MODEL)
IN_WIDTH = sum(IN_SPLITS)
IN_OFFSETS = tuple(sum(IN_SPLITS[:i + 1]) for i in range(len(IN_SPLITS) - 1))

kernel_name = 'hybrid_mla_pool_gated_deepnorm_adaln'


def layer_norm(x, g=None, b=None):
    xf = x.astype(jnp.float32)
    mu = jnp.mean(xf, axis=-1, keepdims=True)
    var = jnp.mean(jnp.square(xf - mu), axis=-1, keepdims=True)
    y = (xf - mu) * lax.rsqrt(var + LN_EPS)
    if g is not None:
        y = y * g.astype(jnp.float32) + b.astype(jnp.float32)
    return y.astype(x.dtype)


def rms_norm(x, g):
    xf = x.astype(jnp.float32)
    y = xf * lax.rsqrt(jnp.mean(jnp.square(xf), axis=-1, keepdims=True) + RMS_EPS)
    return (y * g.astype(jnp.float32)).astype(x.dtype)


def rope_tables(positions, dtype):
    inv_freq = ROPE_THETA ** (-jnp.arange(0, QK_ROPE_DIM, 2, dtype=jnp.float32) / QK_ROPE_DIM)
    ang = positions.astype(jnp.float32)[..., None] * inv_freq
    return jnp.cos(ang)[:, :, None, :].astype(dtype), jnp.sin(ang)[:, :, None, :].astype(dtype)


def apply_rope(x, cos, sin):
    half = QK_ROPE_DIM // 2
    x1, x2 = x[..., :half], x[..., half:]
    return jnp.concatenate([x1 * cos - x2 * sin, x1 * sin + x2 * cos], axis=-1)


def causal_attention(q, k, v):
    B, S, H, Dqk = q.shape
    Dv = v.shape[-1]
    nb = S // Q_BLOCK
    scale = Dqk ** -0.5
    q_blocks = q.reshape(B, nb, Q_BLOCK, H, Dqk).transpose(1, 0, 2, 3, 4)
    starts = jnp.arange(nb, dtype=jnp.int32) * Q_BLOCK
    k_idx = jnp.arange(S, dtype=jnp.int32)

    def one_block(args):
        q_blk, start = args
        s = jnp.einsum('bqhd,bkhd->bhqk', q_blk, k, preferred_element_type=jnp.float32) * scale
        q_idx = start + jnp.arange(Q_BLOCK, dtype=jnp.int32)
        causal = k_idx[None, :] <= q_idx[:, None]
        s = jnp.where(causal[None, None], s, -jnp.inf)
        p = jax.nn.softmax(s, axis=-1).astype(v.dtype)
        return jnp.einsum('bhqk,bkhd->bqhd', p, v)

    out = lax.map(one_block, (q_blocks, starts))
    return out.transpose(1, 0, 2, 3, 4).reshape(B, S, H * Dv)


def mla_mixer(q_lat, kv_lat, positions, q_norm_g, w_q_b, kv_norm_g, w_kv_b):
    B, S, _ = q_lat.shape
    q = jnp.einsum('bsr,re->bse', rms_norm(q_lat, q_norm_g), w_q_b).reshape(B, S, N_HEADS, QK_HEAD_DIM)
    q_nope, q_pe = q[..., :QK_NOPE_DIM], q[..., QK_NOPE_DIM:]
    c_kv, k_pe = kv_lat[..., :KV_LORA_RANK], kv_lat[..., KV_LORA_RANK:]
    kv = jnp.einsum('bsr,re->bse', rms_norm(c_kv, kv_norm_g), w_kv_b).reshape(B, S, N_HEADS, QK_NOPE_DIM + V_HEAD_DIM)
    k_nope, v = kv[..., :QK_NOPE_DIM], kv[..., QK_NOPE_DIM:]
    cos, sin = rope_tables(positions, q.dtype)
    q_pe = apply_rope(q_pe, cos, sin)
    k_pe = apply_rope(k_pe[:, :, None, :], cos, sin)
    q_full = jnp.concatenate([q_nope, q_pe], axis=-1)
    k_full = jnp.concatenate([k_nope, jnp.broadcast_to(k_pe, (B, S, N_HEADS, QK_ROPE_DIM))], axis=-1)
    return causal_attention(q_full, k_full, v)


def pool_mixer(u, w_pool_g, pool_scale):
    B, S, _ = u.shape
    uf = u.astype(jnp.float32)
    cs = jnp.concatenate([jnp.zeros((B, 1, POOL_WIDTH), jnp.float32), lax.cumsum(uf, axis=1)], axis=1)
    t = jnp.arange(S, dtype=jnp.int32)
    pooled = []
    for g, w in enumerate(POOL_WINDOWS):
        sl = slice(g * POOL_GROUP_DIM, (g + 1) * POOL_GROUP_DIM)
        lo = jnp.maximum(t + 1 - w, 0)
        win_sum = cs[:, 1:, sl] - jnp.take(cs[:, :, sl], lo, axis=1)
        count = jnp.minimum(t + 1, w).astype(jnp.float32)[None, :, None]
        pooled.append(win_sum / count - uf[..., sl])
    pooled = jnp.stack(pooled, axis=2).astype(u.dtype)
    mixed = jnp.einsum('bsgi,gio->bsgo', pooled, w_pool_g).reshape(B, S, POOL_WIDTH)
    return mixed * pool_scale


def setup_inputs(seed: int = 0) -> dict:
    key = jax.random.key(seed)
    ks = jax.random.split(key, 18)
    L, D = DEPTH, D_MODEL

    def nrm(k, shape, scale):
        return jax.random.normal(k, shape, jnp.float32) * scale

    return {
        'x': nrm(ks[0], (BATCH, SEQ, D), 1.0),
        'c': nrm(ks[1], (BATCH, D), 1.0),
        'positions': jnp.broadcast_to(jnp.arange(SEQ, dtype=jnp.int32), (BATCH, SEQ)),
        'w_ada': nrm(ks[2], (L, D, 3 * D), 0.1 * D ** -0.5),
        'b_ada': nrm(ks[3], (L, 3 * D), 0.01),
        'w_in': nrm(ks[4], (L, D, IN_WIDTH), D ** -0.5),
        'b_gates': nrm(ks[5], (L, N_BRANCHES * D), 0.01),
        'q_norm_g': 1.0 + nrm(ks[6], (L, Q_LORA_RANK), 0.01),
        'w_q_b': nrm(ks[7], (L, Q_LORA_RANK, N_HEADS * QK_HEAD_DIM), Q_LORA_RANK ** -0.5),
        'kv_norm_g': 1.0 + nrm(ks[8], (L, KV_LORA_RANK), 0.01),
        'w_kv_b': nrm(ks[9], (L, KV_LORA_RANK, N_HEADS * (QK_NOPE_DIM + V_HEAD_DIM)), KV_LORA_RANK ** -0.5),
        'w_mla_o': nrm(ks[10], (L, MLA_WIDTH, D), DEEPNORM_BETA * MLA_WIDTH ** -0.5),
        'w_pool_g': nrm(ks[11], (L, POOL_GROUPS, POOL_GROUP_DIM, POOL_GROUP_DIM), POOL_GROUP_DIM ** -0.5),
        'pool_scale': 1.0 + nrm(ks[12], (L, POOL_WIDTH), 0.02),
        'w_pool_o': nrm(ks[13], (L, POOL_WIDTH, D), DEEPNORM_BETA * POOL_WIDTH ** -0.5),
        'w_out': nrm(ks[14], (L, D, D), DEEPNORM_BETA * D ** -0.5),
        'ln_g': 1.0 + nrm(ks[15], (L, D), 0.01),
        'ln_b': nrm(ks[16], (L, D), 0.01),
    }


def reference(x, c, positions, w_ada, b_ada, w_in, b_gates, q_norm_g, w_q_b, kv_norm_g, w_kv_b,
              w_mla_o, w_pool_g, pool_scale, w_pool_o, w_out, ln_g, ln_b):
    for l in range(DEPTH):
        mod = jnp.einsum('bd,de->be', jax.nn.silu(c), w_ada[l]) + b_ada[l]
        shift, scale, gate = jnp.split(mod[:, None, :], 3, axis=-1)
        h = layer_norm(x) * (1.0 + scale) + shift
        proj = jnp.einsum('bsd,de->bse', h, w_in[l])
        q_lat, kv_lat, mla_gate, pool_in, pool_gate, gate_logits = jnp.split(proj, IN_OFFSETS, axis=-1)
        y_mla = mla_mixer(q_lat, kv_lat, positions, q_norm_g[l], w_q_b[l], kv_norm_g[l], w_kv_b[l])
        y_mla = jnp.einsum('bse,ed->bsd', y_mla * jax.nn.silu(mla_gate), w_mla_o[l])
        y_pool = pool_mixer(pool_in, w_pool_g[l], pool_scale[l])
        y_pool = jnp.einsum('bse,ed->bsd', y_pool * jax.nn.silu(pool_gate), w_pool_o[l])
        g_mla, g_pool = jnp.split(jax.nn.sigmoid(gate_logits + b_gates[l]), N_BRANCHES, axis=-1)
        y = jnp.einsum('bsd,de->bse', g_mla * y_mla + g_pool * y_pool, w_out[l])
        x = layer_norm(DEEPNORM_ALPHA * x + (1.0 + gate) * y, ln_g[l], ln_b[l])
    return x
```

```cpp
#include <hip/hip_runtime.h>
#include <hip/hip_cooperative_groups.h>
#include <cstdio>
#include <cstdint>
namespace cg = cooperative_groups;
namespace pg8 {
#define PG8_LAS __attribute__((address_space(3)))
typedef unsigned short bf16_t;
typedef short bf16x8 __attribute__((ext_vector_type(8)));
typedef float f32x4 __attribute__((ext_vector_type(4)));
typedef unsigned u32x4 __attribute__((ext_vector_type(4)));
constexpr int BM = 256, BK = 64, HALF = 128, HTB = HALF * BK * 2  , STAGE_BYTES = 8 * HTB, NXCD = 8, WGM = 8;

__host__ __device__ __forceinline__ int lds_byte(int r, int c) { const int st = (r >> 4) * 2 + (c >> 5), rr = r & 15, cc = c & 31, ob = rr * 64 + cc * 2; return st * 1024 + (ob ^ (((ob >> 9) & 1) << 5)); }
__host__ __device__ __forceinline__ void stage_rc(int b, int& R, int& C) { const int st = b / 1024, sb = b % 1024, swz = sb ^ (((sb >> 9) & 1) << 5); R = (st >> 1) * 16 + swz / 64; C = (st & 1) * 32 + (swz % 64) / 2; }
__host__ __device__ __forceinline__ int perm32(int rho) { const int n = rho >> 4, i = rho & 15; return 8 * (i >> 2) + 4 * n + (i & 3); }

struct Unit { int pm, pn; };
struct Gemm { const bf16_t* A; const bf16_t* Bt; int M, N, K; };

struct StaticOrder {
    int nM, nN, nwg, G, c;
    __host__ __device__ void init(int M, int N, int G_, int c_) { nM = M / BM; nN = N / BM; nwg = nM * nN; G = G_; c = c_; }
    __host__ __device__ bool next(int i, Unit& u) const {
        const long L = (long)i * G + c; if (L >= nwg) return false;
        int wgid = (int)L; { const int q = nwg / NXCD, r = nwg % NXCD, xcd = wgid % NXCD, off = wgid / NXCD; wgid = (xcd < r ? xcd * (q + 1) : r * (q + 1) + (xcd - r) * q) + off; }
        const int nig = WGM * nN, gid = wgid / nig, fm = gid * WGM, gsz = (nM - fm) < WGM ? (nM - fm) : WGM;
        u.pm = fm + ((wgid % nig) % gsz); u.pn = (wgid % nig) / gsz; return true;
    }
    __device__ __forceinline__ void a_ready(const Unit&) const {}
    __device__ __forceinline__ void done(const Unit&) const {}
};

typedef float f32x2c __attribute__((ext_vector_type(2)));
typedef __bf16 bf16x2c __attribute__((ext_vector_type(2)));
__device__ __forceinline__ unsigned cvt_pk_bf16(float lo, float hi) { const f32x2c v = {lo, hi}; return __builtin_bit_cast(unsigned, __builtin_convertvector(v, bf16x2c)); }
template <class Epi, class Sched, bool ALIGN_EPI = false, bool SP2 = false>
__device__ __forceinline__ void gemm_phase(PG8_LAS unsigned char* lds, const Gemm g, const Sched& S, const Epi& E) {
    int tid_ = threadIdx.x; asm volatile("" : "+v"(tid_));
    const int tid = tid_, wid = __builtin_amdgcn_readfirstlane(tid >> 6), lane = tid & 63, wr = wid >> 2, wc = wid & 3, fr = lane & 15, fq = lane >> 4;
    const int K = g.K, nt = K / BK;
    unsigned voffA[2], voffB[2];
#pragma unroll
    for (int i = 0; i < 2; ++i) { int R, C; stage_rc(tid * 16 + i * 8192, R, C); const int Rb = Epi::PERM ? ((R & ~31) + perm32(R & 31)) : R;
        voffA[i] = (unsigned)(R * K + C) * 2u; voffB[i] = (unsigned)(Rb * K + C) * 2u; }
    const size_t kstep = (size_t)(BK * 2);
    const size_t hstep = (size_t)HALF * K * 2;
    const size_t tstep = 2 * hstep;
    const unsigned ldsw = (unsigned)wid * 1024u;
    const int aoff = lds_byte(wr * 64 + fr, fq * 8), boff = lds_byte(wc * 32 + fr, fq * 8);
#define PG8_SA(b, h) (((b) * 2 + (h)) * HTB)
#define PG8_SB(b, h) ((4 + (b) * 2 + (h)) * HTB)
#define PG8_STAGE(bufoff, gbase, voff) do { _Pragma("unroll") for (int _i = 0; _i < 2; ++_i) \
        __builtin_amdgcn_global_load_lds((const unsigned*)((const char*)(gbase) + (voff)[_i]), (PG8_LAS unsigned*)(lds + (bufoff) + ldsw + _i * 8192), 16, 0, 0); } while (0)
#define PG8_LDA(dst, b, h) do { _Pragma("unroll") for (int m = 0; m < 4; ++m) _Pragma("unroll") for (int k = 0; k < 2; ++k) dst[m][k] = *(const PG8_LAS bf16x8*)(lds + PG8_SA(b, h) + aoff + m * 2048 + k * 1024); } while (0)
#define PG8_LDB(dst, b, h) do { _Pragma("unroll") for (int n = 0; n < 2; ++n) _Pragma("unroll") for (int k = 0; k < 2; ++k) dst[n][k] = *(const PG8_LAS bf16x8*)(lds + PG8_SB(b, h) + boff + n * 2048 + k * 1024); } while (0)
#define PG8_MMA(ai, bj, At, Bt) do { __builtin_amdgcn_s_setprio(1); _Pragma("unroll") for (int m = 0; m < 4; ++m) _Pragma("unroll") for (int n = 0; n < 2; ++n) _Pragma("unroll") for (int k = 0; k < 2; ++k) \
        acc[ai][bj][m][n] = __builtin_amdgcn_mfma_f32_16x16x32_bf16(Bt[n][k], At[m][k], acc[ai][bj][m][n], 0, 0, 0); __builtin_amdgcn_s_setprio(0); } while (0)
#define PG8_WAIT_V(n) asm volatile("s_waitcnt vmcnt(" #n ")" ::: "memory")
#define PG8_WAIT_L(n) asm volatile("s_waitcnt lgkmcnt(" #n ")" ::: "memory")
#define PG8_BAR __builtin_amdgcn_s_barrier()
#define PG8_SCHED __builtin_amdgcn_sched_barrier(0)
    Unit cur, nxt; int ui = 0;
    if (!S.next(0, cur)) return;
    f32x4 acc[2][2][4][2];
#pragma unroll
    for (int a = 0; a < 2; ++a)
#pragma unroll
        for (int b = 0; b < 2; ++b)
#pragma unroll
            for (int m = 0; m < 4; ++m)
#pragma unroll
                for (int n = 0; n < 2; ++n) acc[a][b][m][n] = (f32x4){0.f, 0.f, 0.f, 0.f};
    bf16x8 At[4][2], B0[2][2], B1[2][2];
    const char* cA = (const char*)g.A + (size_t)cur.pm * tstep; const char* cB = (const char*)g.Bt + (size_t)cur.pn * tstep;
    S.a_ready(cur);
    if constexpr (SP2) {
        PG8_STAGE(PG8_SB(0, 0), cB, voffB); PG8_STAGE(PG8_SB(0, 1), cB + hstep, voffB); PG8_STAGE(PG8_SA(0, 0), cA, voffA); PG8_STAGE(PG8_SA(0, 1), cA + hstep, voffA);
        if (wr == 1) PG8_BAR;
        PG8_WAIT_V(2); PG8_BAR;
        PG8_STAGE(PG8_SB(1, 0), cB + kstep, voffB); PG8_STAGE(PG8_SA(1, 0), cA + kstep, voffA); PG8_STAGE(PG8_SB(1, 1), cB + hstep + kstep, voffB);
        PG8_WAIT_V(6); PG8_BAR;
    } else {
        PG8_STAGE(PG8_SB(0, 0), cB, voffB); PG8_STAGE(PG8_SA(0, 0), cA, voffA); PG8_STAGE(PG8_SB(0, 1), cB + hstep, voffB); PG8_STAGE(PG8_SA(0, 1), cA + hstep, voffA);
        if (wr == 1) PG8_BAR;
        PG8_WAIT_V(4); PG8_BAR;
        PG8_STAGE(PG8_SB(1, 0), cB + kstep, voffB); PG8_STAGE(PG8_SA(1, 0), cA + kstep, voffA); PG8_STAGE(PG8_SB(1, 1), cB + hstep + kstep, voffB);
        PG8_WAIT_V(6); PG8_BAR;
    }
    for (;;) {
        const bool has_next = S.next(ui + 1, nxt);
        const char* nA = has_next ? (const char*)g.A + (size_t)nxt.pm * tstep : cA; const char* nB = has_next ? (const char*)g.Bt + (size_t)nxt.pn * tstep : cB;
        for (int t = 0; t < nt; t += 2) {
            const bool last = (t == nt - 2);
            const char* a1 = cA + (size_t)(t + 1) * kstep;
            const char* a2 = last ? nA : cA + (size_t)(t + 2) * kstep; const char* b2 = last ? nB : cB + (size_t)(t + 2) * kstep;
            const char* a3 = a2 + kstep; const char* b3 = b2 + kstep;
            if (last && has_next) S.a_ready(nxt);
            if constexpr (SP2) {
            PG8_LDB(B0, 0, 0); PG8_LDB(B1, 0, 1); PG8_SCHED; PG8_LDA(At, 0, 0); PG8_STAGE(PG8_SA(1, 1), a1 + hstep, voffA);
            PG8_WAIT_V(8); PG8_WAIT_L(0); PG8_BAR; PG8_MMA(0, 0, At, B0); PG8_MMA(0, 1, At, B1); PG8_BAR; PG8_SCHED;
            PG8_LDA(At, 0, 1); PG8_STAGE(PG8_SB(0, 0), b2, voffB); PG8_STAGE(PG8_SB(0, 1), b2 + hstep, voffB); PG8_STAGE(PG8_SA(0, 0), a2, voffA);
            PG8_WAIT_V(8); PG8_WAIT_L(0); PG8_BAR; PG8_MMA(1, 0, At, B0); PG8_MMA(1, 1, At, B1); PG8_BAR; PG8_SCHED;
            PG8_LDB(B0, 1, 0); PG8_LDB(B1, 1, 1); PG8_SCHED; PG8_LDA(At, 1, 0); PG8_STAGE(PG8_SA(0, 1), a2 + hstep, voffA);
            PG8_WAIT_V(8); PG8_WAIT_L(0); PG8_BAR; PG8_MMA(0, 0, At, B0); PG8_MMA(0, 1, At, B1); PG8_BAR; PG8_SCHED;
            PG8_LDA(At, 1, 1); PG8_STAGE(PG8_SB(1, 0), b3, voffB); PG8_STAGE(PG8_SB(1, 1), b3 + hstep, voffB); PG8_STAGE(PG8_SA(1, 0), a3, voffA);
            PG8_WAIT_V(8); PG8_WAIT_L(0); PG8_BAR; PG8_MMA(1, 0, At, B0); PG8_MMA(1, 1, At, B1); PG8_BAR; PG8_SCHED;
            } else {
            PG8_LDB(B0, 0, 0); PG8_SCHED; PG8_LDA(At, 0, 0); PG8_STAGE(PG8_SA(1, 1), a1 + hstep, voffA);
            PG8_WAIT_L(8); PG8_BAR; PG8_WAIT_L(0); PG8_MMA(0, 0, At, B0); PG8_BAR; PG8_SCHED;
            PG8_LDB(B1, 0, 1); PG8_STAGE(PG8_SB(0, 0), b2, voffB);
            PG8_BAR; PG8_WAIT_L(0); PG8_MMA(0, 1, At, B1); PG8_BAR;
            PG8_LDA(At, 0, 1); PG8_STAGE(PG8_SA(0, 0), a2, voffA);
            PG8_BAR; PG8_WAIT_L(0); PG8_MMA(1, 0, At, B0); PG8_BAR; PG8_SCHED;
            PG8_STAGE(PG8_SB(0, 1), b2 + hstep, voffB);
            PG8_WAIT_V(6); PG8_BAR; PG8_MMA(1, 1, At, B1); PG8_BAR;
            PG8_LDB(B0, 1, 0); PG8_SCHED; PG8_LDA(At, 1, 0); PG8_STAGE(PG8_SA(0, 1), a2 + hstep, voffA);
            PG8_WAIT_L(8); PG8_BAR; PG8_WAIT_L(0); PG8_MMA(0, 0, At, B0); PG8_BAR; PG8_SCHED;
            PG8_LDB(B1, 1, 1); PG8_STAGE(PG8_SB(1, 0), b3, voffB);
            PG8_BAR; PG8_WAIT_L(0); PG8_MMA(0, 1, At, B1); PG8_BAR;
            PG8_LDA(At, 1, 1); PG8_STAGE(PG8_SA(1, 0), a3, voffA);
            PG8_BAR; PG8_WAIT_L(0); PG8_MMA(1, 0, At, B0); PG8_BAR; PG8_SCHED;
            PG8_STAGE(PG8_SB(1, 1), b3 + hstep, voffB);
            PG8_WAIT_V(6); PG8_BAR; PG8_MMA(1, 1, At, B1); PG8_BAR;
            }
        }
        if constexpr (ALIGN_EPI) { if (wr == 0) PG8_BAR; }
        if constexpr (!Epi::AFTER_DRAIN) { E(acc, cur, wr, wc, fr, fq); S.done(cur); }
        if (!has_next) break;
#pragma unroll
        for (int a = 0; a < 2; ++a)
#pragma unroll
            for (int b = 0; b < 2; ++b)
#pragma unroll
                for (int m = 0; m < 4; ++m)
#pragma unroll
                    for (int n = 0; n < 2; ++n) acc[a][b][m][n] = (f32x4){0.f, 0.f, 0.f, 0.f};
        cur = nxt; cA = nA; cB = nB; ++ui;
        if constexpr (ALIGN_EPI) { if (wr == 1) PG8_BAR; }
    }
    PG8_WAIT_V(0);
    if constexpr (!ALIGN_EPI) { if (wr == 0) PG8_BAR; }
    PG8_BAR;
    if constexpr (Epi::AFTER_DRAIN) { E.fused(acc, cur, wr, wc, fr, fq, lds, wid, lane); S.done(cur); }
#undef PG8_SA
#undef PG8_SB
#undef PG8_STAGE
#undef PG8_LDA
#undef PG8_LDB
#undef PG8_MMA
#undef PG8_WAIT_V
#undef PG8_WAIT_L
#undef PG8_BAR
#undef PG8_SCHED
}
}

constexpr int SEQ = 16384, DM = 2048, NH = 16, DQK = 192, DNOPE = 128, DROPE = 64, DV = 128;
constexpr int QLR = 512, KVLR = 512, MLAW = 2048, POOLW = 1024, INW = 9280, INW_MAIN = 9216, LATW = 1024;
constexpr float RMS_EPS = 1e-6f, LN_EPS = 1e-5f;
constexpr float DN_ALPHA = 1.189207115002721f;

namespace pg8 {
typedef unsigned u32x2 __attribute__((ext_vector_type(2)));
__device__ __forceinline__ u32x4 pack8(f32x4 a, f32x4 b) { u32x4 w; w.x = cvt_pk_bf16(a[0], a[1]); w.y = cvt_pk_bf16(a[2], a[3]); w.z = cvt_pk_bf16(b[0], b[1]); w.w = cvt_pk_bf16(b[2], b[3]); return w; }
__device__ __forceinline__ float bf_lo(unsigned w) { return __uint_as_float(w << 16); }
__device__ __forceinline__ float bf_hi(unsigned w) { return __uint_as_float(w & 0xffff0000u); }
__device__ __forceinline__ void unpack8(u32x4 w, f32x4& a, f32x4& b) { a = (f32x4){bf_lo(w.x), bf_hi(w.x), bf_lo(w.y), bf_hi(w.y)}; b = (f32x4){bf_lo(w.z), bf_hi(w.z), bf_lo(w.w), bf_hi(w.w)}; }
__device__ __forceinline__ float sigmoid_f(float v) { return __builtin_amdgcn_rcpf(1.f + __expf(-v)); }
__device__ __forceinline__ f32x4 sigmoid4(f32x4 v) { return (f32x4){sigmoid_f(v[0]), sigmoid_f(v[1]), sigmoid_f(v[2]), sigmoid_f(v[3])}; }
__device__ __forceinline__ f32x4 silu4(f32x4 v) { return v * sigmoid4(v); }

#define EPI_FOR(ai, m, bj) _Pragma("unroll") for (int ai = 0; ai < 2; ++ai) _Pragma("unroll") for (int m = 0; m < 4; ++m) _Pragma("unroll") for (int bj = 0; bj < 2; ++bj)
#define EPI_ROWB(ai, m, LD, ES) ((size_t)((ai) * HALF + (m) * 16) * (LD) * (ES))
#define EPI_FENCE(bj) do { if ((bj) == 1) asm volatile("" ::: "memory"); } while (0)

struct EpiIn {
    static constexpr bool PERM = true, AFTER_DRAIN = false;
    float* lat; bf16_t* sgate; float* pool_in; bf16_t* spgate; bf16_t* gates; const float* b_gates;
    __device__ __forceinline__ void operator()(const f32x4 (&acc)[2][2][4][2], const Unit& u, int wr, int wc, int fr, int fq) const {
        const int pn = u.pn, rowu = u.pm * BM + wr * 64, colu = wc * 32;
        if (pn < 4) {
            const unsigned lo = (unsigned)(fr * LATW + 8 * fq) * 4u; char* ub = (char*)lat + ((size_t)rowu * LATW + pn * BM + colu) * 4;
            EPI_FOR(ai, m, bj) { char* p = ub + EPI_ROWB(ai, m, LATW, 4) + bj * (HALF * 4) + lo; *(f32x4*)p = acc[ai][bj][m][0]; *(f32x4*)(p + 16) = acc[ai][bj][m][1]; }
        } else if (pn < 12) {
            const unsigned lo = (unsigned)(fr * MLAW + 8 * fq) * 2u; char* ub = (char*)sgate + ((size_t)rowu * MLAW + (pn - 4) * BM + colu) * 2;
            EPI_FOR(ai, m, bj) { *(u32x4*)(ub + EPI_ROWB(ai, m, MLAW, 2) + bj * (HALF * 2) + lo) = pack8(silu4(acc[ai][bj][m][0]), silu4(acc[ai][bj][m][1])); }
        } else if (pn < 16) {
            const unsigned lo = (unsigned)(fr * POOLW + 8 * fq) * 4u; char* ub = (char*)pool_in + ((size_t)rowu * POOLW + (pn - 12) * BM + colu) * 4;
            EPI_FOR(ai, m, bj) { char* p = ub + EPI_ROWB(ai, m, POOLW, 4) + bj * (HALF * 4) + lo; *(f32x4*)p = acc[ai][bj][m][0]; *(f32x4*)(p + 16) = acc[ai][bj][m][1]; }
        } else if (pn < 20) {
            const unsigned lo = (unsigned)(fr * POOLW + 8 * fq) * 2u; char* ub = (char*)spgate + ((size_t)rowu * POOLW + (pn - 16) * BM + colu) * 2;
            EPI_FOR(ai, m, bj) { *(u32x4*)(ub + EPI_ROWB(ai, m, POOLW, 2) + bj * (HALF * 2) + lo) = pack8(silu4(acc[ai][bj][m][0]), silu4(acc[ai][bj][m][1])); }
        } else {
            f32x4 bv[2][2];
#pragma unroll
            for (int bj = 0; bj < 2; ++bj) { const float* bp = b_gates + (pn - 20) * BM + bj * HALF + colu + 8 * fq; bv[bj][0] = *(const f32x4*)bp; bv[bj][1] = *(const f32x4*)(bp + 4); }
            const unsigned lo = (unsigned)(fr * (2 * DM) + 8 * fq) * 2u; char* ub = (char*)gates + ((size_t)rowu * (2 * DM) + (pn - 20) * BM + colu) * 2;
            EPI_FOR(ai, m, bj) { *(u32x4*)(ub + EPI_ROWB(ai, m, 2 * DM, 2) + bj * (HALF * 2) + lo) = pack8(sigmoid4(acc[ai][bj][m][0] + bv[bj][0]), sigmoid4(acc[ai][bj][m][1] + bv[bj][1])); }
        }
    }
};
struct EpiQ {
    static constexpr bool PERM = true, AFTER_DRAIN = false;
    bf16_t* Q; const float* cs;
    __device__ __forceinline__ void operator()(const f32x4 (&acc)[2][2][4][2], const Unit& u, int wr, int wc, int fr, int fq) const {
        const int pn = u.pn, rowu = u.pm * BM + wr * 64;
        const unsigned lo = (unsigned)(fr * DQK + 8 * fq) * 2u;
        if (pn < 8) {
            char* ub = (char*)Q + (((size_t)(pn * 2) * SEQ + rowu) * DQK + wc * 32) * 2;
            EPI_FOR(ai, m, bj) { *(u32x4*)(ub + EPI_ROWB(ai, m, DQK, 2) + (size_t)bj * ((size_t)SEQ * DQK * 2) + lo) = pack8(acc[ai][bj][m][0], acc[ai][bj][m][1]); }
        } else {
            const int h0 = (pn - 8) * 4 + (wc >> 1), ju = (wc & 1) * 32;
            char* ub = (char*)Q + (((size_t)h0 * SEQ + rowu) * DQK + DNOPE + ju) * 2;
            const unsigned lc = (unsigned)(fr * 64 + 8 * fq) * 4u; const char* cb = (const char*)cs + ((size_t)rowu * 64 + ju) * 4;
            _Pragma("unroll") for (int ai = 0; ai < 2; ++ai) { f32x4 tv[4][2];
                _Pragma("unroll") for (int m = 0; m < 4; ++m) { const char* cp = cb + EPI_ROWB(ai, m, 64, 4) + lc; tv[m][0] = *(const f32x4*)cp; tv[m][1] = *(const f32x4*)(cp + 16); }
                asm volatile("" ::: "memory");
                _Pragma("unroll") for (int m = 0; m < 4; ++m) _Pragma("unroll") for (int bj = 0; bj < 2; ++bj) { const f32x4 t0 = tv[m][0], t1 = tv[m][1];
                    const f32x4 c = (f32x4){t0[0], t0[2], t1[0], t1[2]}, s = (f32x4){t0[1], t0[3], t1[1], t1[3]};
                    const f32x4 x1 = acc[ai][bj][m][0], x2 = acc[ai][bj][m][1];
                    *(u32x4*)(ub + EPI_ROWB(ai, m, DQK, 2) + (size_t)bj * ((size_t)2 * SEQ * DQK * 2) + lo) = pack8(x1 * c - x2 * s, x1 * s + x2 * c); }
                asm volatile("" ::: "memory"); }
        }
    }
};
struct EpiKV {
    static constexpr bool PERM = true, AFTER_DRAIN = false;
    bf16_t* Kn; bf16_t* V;
    __device__ __forceinline__ void operator()(const f32x4 (&acc)[2][2][4][2], const Unit& u, int wr, int wc, int fr, int fq) const {
        const int pn = u.pn, rowu = u.pm * BM + wr * 64;
        const unsigned lo = (unsigned)(fr * 128 + 8 * fq) * 2u;
        char* ub = (char*)(pn < 8 ? Kn : V) + (((size_t)((pn & 7) * 2) * SEQ + rowu) * 128 + wc * 32) * 2;
        EPI_FOR(ai, m, bj) { *(u32x4*)(ub + EPI_ROWB(ai, m, 128, 2) + (size_t)bj * ((size_t)SEQ * 128 * 2) + lo) = pack8(acc[ai][bj][m][0], acc[ai][bj][m][1]); }
    }
};
#define EPI_HALF(ai) _Pragma("unroll") for (int ai = 0; ai < 2; ++ai)
#define EPI_MB(m, bj) _Pragma("unroll") for (int m = 0; m < 4; ++m) _Pragma("unroll") for (int bj = 0; bj < 2; ++bj)
#define EPI_MEMFENCE() asm volatile("" ::: "memory")
struct EpiPool {
    static constexpr bool PERM = true, AFTER_DRAIN = false;
    bf16_t* pmix; const bf16_t* spgate; const float* pool_scale;
    __device__ __forceinline__ void operator()(const f32x4 (&acc)[2][2][4][2], const Unit& u, int wr, int wc, int fr, int fq) const {
        const int g = u.pn, rowu = (u.pm & 63) * BM + wr * 64, colu = g * 256 + wc * 32;
        f32x4 sv[2][2];
#pragma unroll
        for (int bj = 0; bj < 2; ++bj) { const float* sp = pool_scale + colu + bj * HALF + 8 * fq; sv[bj][0] = *(const f32x4*)sp; sv[bj][1] = *(const f32x4*)(sp + 4); }
        const unsigned lo = (unsigned)(fr * POOLW + 8 * fq) * 2u; const size_t uo = ((size_t)rowu * POOLW + colu) * 2;
        EPI_HALF(ai) { u32x4 gw[4][2];
            EPI_MB(m, bj) gw[m][bj] = *(const u32x4*)((const char*)spgate + uo + EPI_ROWB(ai, m, POOLW, 2) + bj * (HALF * 2) + lo);
            EPI_MEMFENCE();
            EPI_MB(m, bj) { f32x4 g0, g1; unpack8(gw[m][bj], g0, g1);
                *(u32x4*)((char*)pmix + uo + EPI_ROWB(ai, m, POOLW, 2) + bj * (HALF * 2) + lo) = pack8(acc[ai][bj][m][0] * sv[bj][0] * g0, acc[ai][bj][m][1] * sv[bj][1] * g1); }
            EPI_MEMFENCE(); }
    }
};
struct EpiMlaO {
    static constexpr bool PERM = true, AFTER_DRAIN = false;
    bf16_t* z; const bf16_t* gates;
    __device__ __forceinline__ void operator()(const f32x4 (&acc)[2][2][4][2], const Unit& u, int wr, int wc, int fr, int fq) const {
        const int rowu = u.pm * BM + wr * 64, colu = u.pn * BM + wc * 32;
        const unsigned loz = (unsigned)(fr * DM + 8 * fq) * 2u, log_ = (unsigned)(fr * (2 * DM) + 8 * fq) * 2u;
        char* zb_ = (char*)z + ((size_t)rowu * DM + colu) * 2; const char* gb_ = (const char*)gates + ((size_t)rowu * (2 * DM) + colu) * 2;
        EPI_HALF(ai) { u32x4 gw[4][2];
            EPI_MB(m, bj) gw[m][bj] = *(const u32x4*)(gb_ + EPI_ROWB(ai, m, 2 * DM, 2) + bj * (HALF * 2) + log_);
            EPI_MEMFENCE();
            EPI_MB(m, bj) { f32x4 g0, g1; unpack8(gw[m][bj], g0, g1);
                *(u32x4*)(zb_ + EPI_ROWB(ai, m, DM, 2) + bj * (HALF * 2) + loz) = pack8(acc[ai][bj][m][0] * g0, acc[ai][bj][m][1] * g1); }
            EPI_MEMFENCE(); }
    }
};
struct EpiPoolO {
    static constexpr bool PERM = true, AFTER_DRAIN = false;
    bf16_t* z; const bf16_t* gates;
    __device__ __forceinline__ void operator()(const f32x4 (&acc)[2][2][4][2], const Unit& u, int wr, int wc, int fr, int fq) const {
        const int rowu = u.pm * BM + wr * 64, colu = u.pn * BM + wc * 32;
        const unsigned loz = (unsigned)(fr * DM + 8 * fq) * 2u, log_ = (unsigned)(fr * (2 * DM) + 8 * fq) * 2u;
        char* zb_ = (char*)z + ((size_t)rowu * DM + colu) * 2; const char* gb_ = (const char*)gates + ((size_t)rowu * (2 * DM) + DM + colu) * 2;
        EPI_HALF(ai) { u32x4 gw[4][2], zw[4][2];
            EPI_MB(m, bj) { gw[m][bj] = *(const u32x4*)(gb_ + EPI_ROWB(ai, m, 2 * DM, 2) + bj * (HALF * 2) + log_); zw[m][bj] = *(const u32x4*)(zb_ + EPI_ROWB(ai, m, DM, 2) + bj * (HALF * 2) + loz); }
            EPI_MEMFENCE();
            EPI_MB(m, bj) { f32x4 g0, g1, z0, z1; unpack8(gw[m][bj], g0, g1); unpack8(zw[m][bj], z0, z1);
                *(u32x4*)(zb_ + EPI_ROWB(ai, m, DM, 2) + bj * (HALF * 2) + loz) = pack8(z0 + acc[ai][bj][m][0] * g0, z1 + acc[ai][bj][m][1] * g1); }
            EPI_MEMFENCE(); }
    }
};
struct EpiOut {
    static constexpr bool PERM = true, AFTER_DRAIN = false;
    float* out; const float* x; const float* mod;
    __device__ __forceinline__ void operator()(const f32x4 (&acc)[2][2][4][2], const Unit& u, int wr, int wc, int fr, int fq) const {
        const int rowu = u.pm * BM + wr * 64, colu = u.pn * BM + wc * 32;
        f32x4 gv[2][2];
#pragma unroll
        for (int bj = 0; bj < 2; ++bj) { const float* gp = mod + 2 * DM + bj * HALF + colu + 8 * fq; gv[bj][0] = *(const f32x4*)gp + 1.f; gv[bj][1] = *(const f32x4*)(gp + 4) + 1.f; }
        const unsigned lo = (unsigned)(fr * DM + 8 * fq) * 4u; const size_t uo = ((size_t)rowu * DM + colu) * 4;
        EPI_HALF(ai) { f32x4 xv[4][2][2];
            EPI_MB(m, bj) { const char* xp = (const char*)x + uo + EPI_ROWB(ai, m, DM, 4) + bj * (HALF * 4) + lo; xv[m][bj][0] = *(const f32x4*)xp; xv[m][bj][1] = *(const f32x4*)(xp + 16); }
            EPI_MEMFENCE();
            EPI_MB(m, bj) { char* op = (char*)out + uo + EPI_ROWB(ai, m, DM, 4) + bj * (HALF * 4) + lo;
                *(f32x4*)op = xv[m][bj][0] * DN_ALPHA + gv[bj][0] * acc[ai][bj][m][0]; *(f32x4*)(op + 16) = xv[m][bj][1] * DN_ALPHA + gv[bj][1] * acc[ai][bj][m][1]; }
            EPI_MEMFENCE(); }
    }
};
struct EpiKpe {
    static constexpr bool PERM = true, AFTER_DRAIN = false;
    bf16_t* Kp; const float* cs;
    __device__ __forceinline__ void operator()(const f32x4 (&acc)[2][2][4][2], const Unit& u, int wr, int wc, int fr, int fq) const {
        if (wc >= 2) return;
        const int rowu = u.pm * BM + wr * 64, ju = wc * 32;
        const unsigned lo = (unsigned)(fr * DROPE + 8 * fq) * 2u, lc = (unsigned)(fr * 64 + 8 * fq) * 4u;
        char* ub = (char*)Kp + ((size_t)rowu * DROPE + ju) * 2; const char* cb = (const char*)cs + ((size_t)rowu * 64 + ju) * 4;
        _Pragma("unroll") for (int ai = 0; ai < 2; ++ai) { f32x4 tv[4][2];
            _Pragma("unroll") for (int m = 0; m < 4; ++m) { const char* cp = cb + EPI_ROWB(ai, m, 64, 4) + lc; tv[m][0] = *(const f32x4*)cp; tv[m][1] = *(const f32x4*)(cp + 16); }
            asm volatile("" ::: "memory");
            _Pragma("unroll") for (int m = 0; m < 4; ++m) { const f32x4 t0 = tv[m][0], t1 = tv[m][1];
                const f32x4 c = (f32x4){t0[0], t0[2], t1[0], t1[2]}, s = (f32x4){t0[1], t0[3], t1[1], t1[3]};
                const f32x4 x1 = acc[ai][0][m][0], x2 = acc[ai][0][m][1];
                *(u32x4*)(ub + EPI_ROWB(ai, m, DROPE, 2) + lo) = pack8(x1 * c - x2 * s, x1 * s + x2 * c); }
            asm volatile("" ::: "memory"); }
    }
};
struct KpeOrder {
    int G, c;
    __device__ bool next(int i, Unit& u) const { const int L = i * G + c; if (L >= SEQ / BM) return false; u.pm = L; u.pn = 0; return true; }
    __device__ __forceinline__ void a_ready(const Unit&) const {}
    __device__ __forceinline__ void done(const Unit&) const {}
};
struct PoolOrder {
    int G, c;
    __device__ bool next(int i, Unit& u) const { const int L = i * G + c; if (L >= 256) return false; u.pm = L; u.pn = L >> 6; return true; }
    __device__ __forceinline__ void a_ready(const Unit&) const {}
    __device__ __forceinline__ void done(const Unit&) const {}
};
}

namespace att {
typedef unsigned short bf16;
typedef short bf16x8 __attribute__((ext_vector_type(8)));
typedef short s16x4 __attribute__((ext_vector_type(4)));
typedef float f32x16 __attribute__((ext_vector_type(16)));
typedef float f32x4 __attribute__((ext_vector_type(4)));
typedef unsigned u32x4 __attribute__((ext_vector_type(4)));
constexpr int NW = 8, QBLK = 32, KVBLK = 64, QB = NW * QBLK, NQB = SEQ / QB;
constexpr int SHM_V = KVBLK * DV * 2, SHM_K = KVBLK * DQK * 2;
constexpr int NVB = 3;
constexpr int LDS_BYTES = NVB * SHM_V + 2 * SHM_K + NW * 64 * 4;
constexpr float SCALE = 0.07216878364870322f;
constexpr float THR = 8.f;
constexpr int OPITCH = MLAW;

#define KSWZ(row, colB) ((row) * 384 + ((colB) ^ ((((row) >> 1) & 7) << 4)))
#define SBAR() __builtin_amdgcn_sched_barrier(0)
__device__ __forceinline__ int v_st(int k, int c) { const int kk = (k & ~0xC) | ((k & 4) << 1) | ((k & 8) >> 1); return ((kk >> 3) * 4 + (c >> 5)) * 512 + ((kk & 7) * 32 + (c & 31)) * 2; }
__device__ __forceinline__ int v_rd_base(int lane) { return ((lane & 3) << 3) | (((lane >> 2) & 3) << 6) | (((lane >> 4) & 1) << 5) | (((lane >> 5) & 1) << 8); }
constexpr int v_rd_off(int d0, int ks, int half) { return d0 * 512 + ks * 4096 + half * 2048; }
__device__ __forceinline__ int crow(int r, int hi) { return (r & 3) + 8 * (r >> 2) + 4 * hi; }
__device__ __forceinline__ unsigned cvtpk(float lo, float hi) { return pg8::cvt_pk_bf16(lo, hi); }
__device__ __forceinline__ bf16x8 ld8(const bf16* p) { return *reinterpret_cast<const bf16x8*>(p); }
__device__ __forceinline__ void mask_tile(f32x16& p0, f32x16& p1, int dq) {
    const float NEG = -__builtin_inff();
#pragma unroll
    for (int r = 0; r < 16; ++r) { const int c = (r & 3) + 8 * (r >> 2);
        if (dq - c < 0) p0[r] = NEG;
        if (dq - c - 32 < 0) p1[r] = NEG; }
}
__device__ __forceinline__ void partialSM(f32x16& p0, f32x16& p1, float& m_reg, float& mn, float& alpha) {
    float pmax = p0[0]; for (int r = 1; r < 16; ++r) pmax = fmaxf(pmax, p0[r]); for (int r = 0; r < 16; ++r) pmax = fmaxf(pmax, p1[r]);
    { auto rr = __builtin_amdgcn_permlane32_swap(__float_as_uint(pmax), __float_as_uint(pmax), false, false);
      pmax = fmaxf(__uint_as_float(rr[0]), __uint_as_float(rr[1])); }
    constexpr float C2 = 1.4426950408889634f * SCALE;
    if (__builtin_expect(__all((pmax - m_reg) * SCALE <= THR), 1)) { mn = m_reg; alpha = 1.f; }
    else { mn = fmaxf(m_reg, pmax); alpha = __builtin_amdgcn_exp2f((m_reg - mn) * C2); m_reg = mn; }
    const float mnL = -mn * C2;
    for (int r = 0; r < 16; ++r) p0[r] = fmaf(p0[r], C2, mnL); for (int r = 0; r < 16; ++r) p1[r] = fmaf(p1[r], C2, mnL);
    for (int r = 0; r < 16; ++r) p0[r] = __builtin_amdgcn_exp2f(p0[r]);
}
__device__ __forceinline__ void finishSM(f32x16& p0, f32x16& p1, float alpha, float& l_reg, bf16x8& pa0, bf16x8& pa1, bf16x8& pa2, bf16x8& pa3) {
    for (int r = 0; r < 16; ++r) p1[r] = __builtin_amdgcn_exp2f(p1[r]);
    float ps = 0; for (int r = 0; r < 16; ++r) ps += p0[r]; for (int r = 0; r < 16; ++r) ps += p1[r];
    { auto rr = __builtin_amdgcn_permlane32_swap(__float_as_uint(ps), __float_as_uint(ps), false, false);
      ps = __uint_as_float(rr[0]) + __uint_as_float(rr[1]); }
    l_reg = l_reg * alpha + ps;
#define PK4(P, B_, OUT) do { unsigned a0 = cvtpk(P[B_+0], P[B_+1]), a1 = cvtpk(P[B_+2], P[B_+3]);                          \
        unsigned b0 = cvtpk(P[B_+4], P[B_+5]), b1 = cvtpk(P[B_+6], P[B_+7]);                                             \
        auto r0 = __builtin_amdgcn_permlane32_swap(a0, b0, false, false); auto r1 = __builtin_amdgcn_permlane32_swap(a1, b1, false, false); \
        u32x4 w = {r0[0], r1[0], r0[1], r1[1]}; OUT = *reinterpret_cast<bf16x8*>(&w); } while (0)
    PK4(p0, 0, pa0); PK4(p0, 8, pa1); PK4(p1, 0, pa2); PK4(p1, 8, pa3);
#undef PK4
}
template <int KB>
__device__ __forceinline__ void qkt(f32x16& p0, f32x16& p1, const char* K_lds, int r32, int hi, const bf16x8* qr) {
    p0 = f32x16{}; p1 = f32x16{};
    const char* kb[4];
#pragma unroll
    for (int dd = 0; dd < 4; ++dd) kb[dd] = K_lds + KB * SHM_K + KSWZ(r32, (dd * 16 + hi * 8) * 2);
#pragma unroll
    for (int d0 = 0; d0 < 12; ++d0) { const char* a = kb[d0 & 3] + (d0 >> 2) * 128;
        bf16x8 b0 = *reinterpret_cast<const bf16x8*>(a);
        bf16x8 b1 = *reinterpret_cast<const bf16x8*>(a + 32 * 384);
        p0 = __builtin_amdgcn_mfma_f32_32x32x16_bf16(b0, qr[d0], p0, 0, 0, 0);
        p1 = __builtin_amdgcn_mfma_f32_32x32x16_bf16(b1, qr[d0], p1, 0, 0, 0); }
}
template <int VB>
__device__ __forceinline__ void pv_tile(f32x16* o, int vb0, bf16x8 pa0, bf16x8 pa1, bf16x8 pa2, bf16x8 pa3) {
#define TRRD(dst, off) asm volatile("ds_read_b64_tr_b16 %0, %1 offset:%2" : "=&v"(dst) : "v"(vb0), "i"(off) : "memory")
#define PV_D0(d0) do { s16x4 l0, l1, l2, l3, h0, h1, h2, h3; constexpr int b_ = VB * SHM_V + v_rd_off(d0, 0, 0); \
        TRRD(l0, b_); TRRD(h0, b_ + 2048); TRRD(l1, b_ + 4096); TRRD(h1, b_ + 6144); TRRD(l2, b_ + 8192); TRRD(h2, b_ + 10240); TRRD(l3, b_ + 12288); TRRD(h3, b_ + 14336); \
        asm volatile("s_waitcnt lgkmcnt(0)" ::: "memory"); SBAR();   \
        o[d0] = __builtin_amdgcn_mfma_f32_32x32x16_bf16(pa0, (bf16x8){l0[0], l0[1], l0[2], l0[3], h0[0], h0[1], h0[2], h0[3]}, o[d0], 0, 0, 0);   \
        o[d0] = __builtin_amdgcn_mfma_f32_32x32x16_bf16(pa1, (bf16x8){l1[0], l1[1], l1[2], l1[3], h1[0], h1[1], h1[2], h1[3]}, o[d0], 0, 0, 0);   \
        o[d0] = __builtin_amdgcn_mfma_f32_32x32x16_bf16(pa2, (bf16x8){l2[0], l2[1], l2[2], l2[3], h2[0], h2[1], h2[2], h2[3]}, o[d0], 0, 0, 0);   \
        o[d0] = __builtin_amdgcn_mfma_f32_32x32x16_bf16(pa3, (bf16x8){l3[0], l3[1], l3[2], l3[3], h3[0], h3[1], h3[2], h3[3]}, o[d0], 0, 0, 0); } while (0)
    PV_D0(0); PV_D0(1); PV_D0(2); PV_D0(3);
#undef PV_D0
#undef TRRD
}
#ifndef DRY_NOSM
#define DRY_NOSM 0
#endif
#ifndef DRY_NOSTAGE
#define DRY_NOSTAGE 0
#endif
#ifndef DRY_WRAP
#define DRY_WRAP 0
#endif
__device__ __forceinline__ void cheapSM(f32x16& p0, f32x16& p1, float& l_reg, bf16x8& pa0, bf16x8& pa1, bf16x8& pa2, bf16x8& pa3) {
    l_reg += fabsf(p0[0]) + fabsf(p1[0]);
#define PK4(P, B_, OUT) do { unsigned a0 = cvtpk(P[B_+0], P[B_+1]), a1 = cvtpk(P[B_+2], P[B_+3]);                          \
        unsigned b0 = cvtpk(P[B_+4], P[B_+5]), b1 = cvtpk(P[B_+6], P[B_+7]);                                             \
        auto r0 = __builtin_amdgcn_permlane32_swap(a0, b0, false, false); auto r1 = __builtin_amdgcn_permlane32_swap(a1, b1, false, false); \
        u32x4 w = {r0[0], r1[0], r0[1], r1[1]}; OUT = *reinterpret_cast<bf16x8*>(&w); } while (0)
    PK4(p0, 0, pa0); PK4(p0, 8, pa1); PK4(p1, 0, pa2); PK4(p1, 8, pa3);
#undef PK4
}
struct BlockRef { const bf16* Q; const bf16* Kn; const bf16* Kp; const bf16* V; bf16* O; int P0; };
#define VMW() asm volatile("s_waitcnt vmcnt(0)" ::: "memory")
typedef __attribute__((address_space(3))) unsigned lds_u32;
#define STAGE(kbf, vbf, k0) do {                                                                                                                 \
        _Pragma("unroll") for (int i_ = 0; i_ < 2; ++i_) __builtin_amdgcn_global_load_lds((const unsigned*)(pV[i_] + (size_t)(k0) * (DV * 2)),    \
            (lds_u32*)(uintptr_t)(ldsV + (vbf) * SHM_V + (wid * 2 + i_) * 1024), 16, 0, 0);                                                      \
        _Pragma("unroll") for (int i_ = 0; i_ < 3; ++i_) __builtin_amdgcn_global_load_lds((const unsigned*)(pK[i_] + (size_t)(k0) * stK[i_]),     \
            (lds_u32*)(uintptr_t)(ldsK + (kbf) * SHM_K + (wid * 3 + i_) * 1024), 16, 0, 0); } while (0)
__device__ __forceinline__ void attn_block(const BlockRef& cur, char* lds, bool rev, bool dry = false) {
    int tid_ = threadIdx.x; asm volatile("" : "+v"(tid_));
    const int tid = tid_, wid = __builtin_amdgcn_readfirstlane(tid >> 6), lane = tid & 63, r32 = lane & 31, hi = lane >> 5;
    const int NT = cur.P0 / KVBLK + QB / KVBLK;
    const int qlo = cur.P0 + wid * QBLK, qm = qlo + r32 - 4 * hi;
    char* V_lds = lds; char* K_lds = lds + NVB * SHM_V;
    float* ws = (float*)(lds + NVB * SHM_V + 2 * SHM_K) + wid * 64; float* li_l = ws, * al_l = ws + 32;
    const int vb0 = (int)(uintptr_t)V_lds + v_rd_base(lane);
    const unsigned ldsV = (unsigned)(uintptr_t)V_lds, ldsK = (unsigned)(uintptr_t)K_lds;
    const unsigned lo_q = (unsigned)(r32 * DQK + hi * 8) * 2u, lo_o = (unsigned)(hi * 4 * OPITCH + (r32 & ~1)) * 2u;
    const char* pK[3]; unsigned stK[3]; const char* pV[2];
#pragma unroll
    for (int i = 0; i < 3; ++i) { const int o_ = (wid * 3 + i) * 1024 + lane * 16, r = o_ / 384, s = (o_ % 384) / 16, c = (s & ~7) | ((s ^ (r >> 1)) & 7);
        if (c < 16) { pK[i] = (const char*)cur.Kn + (r * DNOPE + c * 8) * 2; stK[i] = DNOPE * 2; } else { pK[i] = (const char*)cur.Kp + (r * DROPE + (c - 16) * 8) * 2; stK[i] = DROPE * 2; } }
#pragma unroll
    for (int i = 0; i < 2; ++i) { const int o_ = (wid * 2 + i) * 1024 + lane * 16, st = o_ / 512, w2 = (o_ % 512) / 2, kk = (st / 4) * 8 + w2 / 32, c = (st % 4) * 32 + (w2 % 32);
        const int k = (kk & ~0xC) | ((kk & 4) << 1) | ((kk & 8) >> 1); pV[i] = (const char*)cur.V + (k * DV + c) * 2; }
    bf16x8 qr[12];
    { const char* qb_ = (const char*)cur.Q + (size_t)wid * (QBLK * DQK * 2);
#pragma unroll
      for (int d0 = 0; d0 < 12; ++d0) qr[d0] = *(const bf16x8*)(qb_ + lo_q + d0 * 32); }
    const bool grpB = wid >= 4;
#define TILE_KB(t) ((rev ? NT - 1 - (t) : (t)) * KVBLK)
    STAGE(0, 0, TILE_KB(0)); VMW();
    __syncthreads();
    float m_reg = -1e30f, l_reg = 0; f32x16 o[4] = {};
#define RESC(a) do { if (__any((a) < 1.f)) { if (hi == 0) al_l[r32] = (a); asm volatile("s_waitcnt lgkmcnt(0)" ::: "memory");              \
                     for (int d_ = 0; d_ < 4; ++d_) for (int r = 0; r < 16; ++r) o[d_][r] *= al_l[crow(r, hi)]; } } while (0)
#define SM_PV(tt, vslot) do { const int kq_ = TILE_KB(tt);                                                                    \
        if (kq_ + KVBLK - 1 > qlo) mask_tile(p0, p1, qm - kq_);                                                               \
        float mn, al = 1.f; bf16x8 pa0, pa1, pa2, pa3;                                                                         \
        if (DRY_NOSM && dry) { cheapSM(p0, p1, l_reg, pa0, pa1, pa2, pa3); } else { partialSM(p0, p1, m_reg, mn, al); finishSM(p0, p1, al, l_reg, pa0, pa1, pa2, pa3); } \
        RESC(al); SBAR();                                                                                                     \
        pv_tile<0>(o, vb0 + (vslot) * SHM_V, pa0, pa1, pa2, pa3); } while (0)
    if (!grpB) {
        int vs = 0;
        for (int t = 0; t <= NT; ++t) { const int kbuf = t & 1, vn = vs == 2 ? 0 : vs + 1;
            if (t + 1 < NT && !(DRY_NOSTAGE && dry)) STAGE(kbuf ^ 1, vn, TILE_KB(t + 1));
            if (t < NT) { f32x16 p0, p1; SBAR(); qkt<0>(p0, p1, K_lds + kbuf * SHM_K, r32, hi, qr); SM_PV(t, vs); }
            VMW(); __syncthreads();
            vs = vn; }
    } else {
        int vs = 0; f32x16 p0, p1;
        if (!(DRY_NOSTAGE && dry)) STAGE(1, 1, TILE_KB(1));
        SBAR(); qkt<0>(p0, p1, K_lds, r32, hi, qr);
        VMW(); __syncthreads();
        vs = 1;
        for (int t = 1; t <= NT; ++t) { const int kbuf = t & 1, vn = vs == 2 ? 0 : vs + 1, vp = vs == 0 ? 2 : vs - 1;
            if (t + 1 < NT && !(DRY_NOSTAGE && dry)) STAGE(kbuf ^ 1, vn, TILE_KB(t + 1));
            SM_PV(t - 1, vp);
            if (t < NT) { SBAR(); qkt<0>(p0, p1, K_lds + kbuf * SHM_K, r32, hi, qr); }
            VMW(); __syncthreads();
            vs = vn; }
    }
#undef SM_PV
#undef TILE_KB
#undef STEP
#undef RESC
    if (hi == 0) li_l[r32] = l_reg; asm volatile("s_waitcnt lgkmcnt(0)" ::: "memory");
    char* ob_ = (char*)cur.O + (size_t)wid * (QBLK * OPITCH * 2);
    unsigned gw[16][4];
#pragma unroll
    for (int r = 0; r < 16; ++r) { const unsigned* gp = (const unsigned*)(ob_ + (size_t)((r & 3) + 8 * (r >> 2)) * (OPITCH * 2) + lo_o);
#pragma unroll
        for (int d0 = 0; d0 < 4; ++d0) gw[r][d0] = gp[d0 * 16]; }
    asm volatile("" ::: "memory");
#pragma unroll
    for (int r = 0; r < 16; ++r) { const float rli = __builtin_amdgcn_rcpf(li_l[crow(r, hi)]);
        unsigned* gp = (unsigned*)(ob_ + (size_t)((r & 3) + 8 * (r >> 2)) * (OPITCH * 2) + lo_o);
#pragma unroll
        for (int d0 = 0; d0 < 4; ++d0) { const float v = o[d0][r] * rli; const float vn = __shfl_xor(v, 1);
            if ((r32 & 1) == 0 && (!dry || l_reg < 0.f)) gp[d0 * 16] = cvtpk(v * __uint_as_float(gw[r][d0] << 16), vn * __uint_as_float(gw[r][d0] & 0xffff0000u)); } }
    __syncthreads();
}
#undef VMW
#undef STAGE
struct Tensors { const bf16* Q; const bf16* Kn; const bf16* Kp; const bf16* V; bf16* O; };
__device__ __forceinline__ BlockRef mk_ref(const Tensors& T, int L, int pass) {
    const int h = L >> 5, x = L & 31, qb = pass ? x : (NQB - 1 - x); BlockRef r;
    r.Q = T.Q + ((size_t)h * SEQ + (size_t)qb * QB) * DQK; r.Kn = T.Kn + (size_t)h * SEQ * DNOPE; r.Kp = T.Kp; r.V = T.V + (size_t)h * SEQ * DV;
    r.O = T.O + (size_t)qb * QB * OPITCH + h * DV; r.P0 = qb * QB; return r;
}
__device__ __forceinline__ void attn_phase(char* lds, const Tensors& T, int first, int stride, bool dry = false) {
    constexpr int total = NH * (NQB / 2);
    for (int L = first; L < total; L += stride)
        for (int pass = 0; pass < 2; ++pass) { const BlockRef cur = mk_ref(T, L, pass); attn_block(cur, lds, pass != 0, dry); }
}
#undef KSWZ
#undef SBAR
}

constexpr int NWAVES = 8, NTHREADS = NWAVES * 64;
constexpr int LDS_BYTES = 131072 + 1024;
constexpr size_t MiB = 1u << 20;
constexpr size_t WS_MOD = 0;
constexpr size_t WS_WIN = 1 * MiB, WS_WKPE = 37 * MiB, WS_WQB = 38 * MiB, WS_WKVB = 41 * MiB, WS_WMLAO = 45 * MiB, WS_WPOOLG = 53 * MiB, WS_WPOOLO = 54 * MiB, WS_WOUT = 58 * MiB;
constexpr size_t WS_R1 = 66 * MiB;
constexpr size_t WS_SGATE = 130 * MiB;
constexpr size_t WS_SPGATE = 194 * MiB;
constexpr size_t WS_GATES = 226 * MiB;
constexpr size_t WS_LAT = 354 * MiB;
constexpr size_t WS_POOLIN = 422 * MiB;
constexpr size_t WS_Q = 354 * MiB;
constexpr size_t WS_PMIX = 450 * MiB;
constexpr size_t WS_KVN = 486 * MiB;
constexpr size_t WS_CS = 502 * MiB;
constexpr size_t WS_END = 506 * MiB;
constexpr size_t DO_KN = 0, DO_KP = 64 * MiB, DO_POOLED = 66 * MiB, DO_QN = 98 * MiB;
static_assert(WS_LAT + (size_t)SEQ * LATW * 4 <= WS_POOLIN && WS_Q + (size_t)NH * SEQ * DQK * 2 <= WS_PMIX && WS_PMIX + (size_t)SEQ * POOLW * 2 <= WS_KVN && WS_CS + (size_t)SEQ * 64 * 4 <= WS_END, "ws map");
static_assert(WS_WIN + (size_t)INW_MAIN * DM * 2 <= WS_WKPE && WS_WKPE + (size_t)256 * DM * 2 <= WS_WQB && WS_WOUT + (size_t)DM * DM * 2 <= WS_R1 && DO_QN + (size_t)SEQ * QLR * 2 <= 128 * MiB, "ws map 2");

#define LAS __attribute__((address_space(3)))
typedef unsigned short bf16_t;
typedef float f32x4 __attribute__((ext_vector_type(4)));
typedef unsigned u32x4 __attribute__((ext_vector_type(4)));
typedef unsigned u32x2 __attribute__((ext_vector_type(2)));
__device__ __forceinline__ unsigned pk2(float lo, float hi) { return pg8::cvt_pk_bf16(lo, hi); }
__device__ __forceinline__ float wave_sum(float v) {
#pragma unroll
    for (int o = 1; o < 64; o <<= 1) v += __shfl_xor(v, o);
    return v;
}
__device__ __forceinline__ int ropeperm(int j) { const int blk = j >> 3, w = j & 7; return (w < 4) ? 4 * blk + w : 32 + 4 * blk + (w - 4); }
template <int MAP> __device__ __forceinline__ int src_col(int r) {
    if (MAP == 1) { return r < 1024 ? r : r + 64; }
    if (MAP == 4) { return r < 64 ? 1024 + ropeperm(r) : -1; }
    if (MAP == 2) { if (r < 2048) return (r >> 7) * DQK + (r & 127); const int q = r - 2048; return (q >> 6) * DQK + DNOPE + ropeperm(q & 63); }
    if (MAP == 3) { if (r < 2048) return (r >> 7) * 256 + (r & 127); const int q = r - 2048; return (q >> 7) * 256 + 128 + (q & 127); }
    return r;
}
template <int MAP> __device__ __forceinline__ void transpose_item(const float* W, int K, int Nsrc, int Ndst, bf16_t* WT, LAS float* scr, int item, int lane) {
    const int nblk = Ndst / 32, kb = item / nblk, nb = item % nblk, k0 = 64 * kb, n0 = 32 * nb;
    const int sc = src_col<MAP>(n0 + (lane & 31));
    float tv_[32];
#pragma unroll
    for (int i = 0; i < 32; ++i) { const int kk = 2 * i + (lane >> 5); tv_[i] = sc >= 0 ? W[(size_t)(k0 + kk) * Nsrc + sc] : 0.f; }
#pragma unroll
    for (int i = 0; i < 32; ++i) { const int kk = 2 * i + (lane >> 5); scr[kk * 33 + (lane & 31)] = tv_[i]; }
    asm volatile("s_waitcnt lgkmcnt(0)" ::: "memory");
    const int c = lane & 7;
#pragma unroll
    for (int j = 0; j < 4; ++j) { const int n = (lane >> 3) + 8 * j; const LAS float* s = scr + (8 * c) * 33 + n;
        u32x4 o; o.x = pk2(s[0 * 33], s[1 * 33]); o.y = pk2(s[2 * 33], s[3 * 33]); o.z = pk2(s[4 * 33], s[5 * 33]); o.w = pk2(s[6 * 33], s[7 * 33]);
        *(u32x4*)(WT + (size_t)(n0 + n) * K + k0 + 8 * c) = o; }
    asm volatile("s_waitcnt lgkmcnt(0)" ::: "memory");
}

#define XB_TMO      128
#define XB_XCNT(j)  (256  + 64 * (j))
#define XB_XSUB(j)  (1280 + 64 * (j))
#define XB_XGEN(j)  (2304 + 64 * (j))
#define XB_TOP      3328
#define XB_TOPGEN   3392
#define XCD_BAR_WORDS 3456
#define XB_SPIN_CAP (1u << 18)

__device__ __forceinline__ unsigned xb_ld(unsigned* p)              { return __hip_atomic_load(p, __ATOMIC_RELAXED, __HIP_MEMORY_SCOPE_AGENT); }
__device__ __forceinline__ unsigned xb_add(unsigned* p, unsigned v) { return __hip_atomic_fetch_add(p, v, __ATOMIC_RELAXED, __HIP_MEMORY_SCOPE_AGENT); }
__device__ __forceinline__ unsigned xb_xcc_id() { return (unsigned)__builtin_amdgcn_s_getreg((3 << 11) | 20) & 0xFu; }
#define XB_SPIN(cond, bar) do { unsigned _sp = 0; while (cond) { __builtin_amdgcn_s_sleep(1); \
    if ((++_sp & 255u) == 0u) { if (xb_ld(&(bar)[XB_TMO])) break; if (_sp > XB_SPIN_CAP) { atomicAdd(&(bar)[XB_TMO], 1u); break; } } } } while (0)

struct XcdBarrier {
    unsigned* bar; unsigned x;
    volatile LAS unsigned* st;
};

__device__ __forceinline__ XcdBarrier xcd_barrier_post(unsigned* bar, volatile LAS unsigned* st) {
    XcdBarrier b; b.bar = bar; b.x = xb_xcc_id(); b.st = st;
    if (threadIdx.x == 0) (void)xb_add(&bar[XB_XCNT(b.x)], 1u);
    return b;
}
__device__ __forceinline__ void xcd_barrier_complete(unsigned* bar, unsigned x, unsigned& nloc, unsigned& nx) {
    const unsigned G = gridDim.x * gridDim.y * gridDim.z;
    unsigned sum, cnt, mine, sp = 0u;
    for (;;) {
        sum = 0u; cnt = 0u; mine = 0u;
#pragma unroll
        for (unsigned j = 0; j < 16; ++j) { const unsigned c = xb_ld(&bar[XB_XCNT(j)]); sum += c; cnt += (c > 0u) ? 1u : 0u; mine = (j == x) ? c : mine; }
        if (sum == G) break;
        __builtin_amdgcn_s_sleep(1);
        if ((++sp & 255u) == 0u) { if (xb_ld(&bar[XB_TMO])) break; if (sp > XB_SPIN_CAP) { atomicAdd(&bar[XB_TMO], 1u); break; } }
    }
    nloc = mine > 0u ? mine : 1u; nx = cnt > 0u ? cnt : 1u;
}

__device__ __forceinline__ void xcd_barrier(const XcdBarrier& b) {
    asm volatile("s_waitcnt vmcnt(0)" ::: "memory");
    __syncthreads();
    if (threadIdx.x == 0) {
        unsigned* bar = b.bar;
        __builtin_amdgcn_s_waitcnt(0);
        unsigned nloc = b.st[0], nx = b.st[1];
        if (nloc == 0u) { xcd_barrier_complete(bar, b.x, nloc, nx); b.st[0] = nloc; b.st[1] = nx; }
        const unsigned old = xb_add(&bar[XB_XSUB(b.x)], 1u);
        const unsigned gen = old / nloc;
        if (old + 1u == (gen + 1u) * nloc) {
            __builtin_amdgcn_fence(__ATOMIC_RELEASE, "agent");
            asm volatile("s_waitcnt vmcnt(0)" ::: "memory");
            const unsigned og = xb_add(&bar[XB_TOP], 1u);
            const unsigned tg = og / nx;
            if (og + 1u == (tg + 1u) * nx) xb_add(&bar[XB_TOPGEN], 1u);
            else XB_SPIN(xb_ld(&bar[XB_TOPGEN]) == tg, bar);
            __builtin_amdgcn_fence(__ATOMIC_ACQUIRE, "agent");
            xb_add(&bar[XB_XGEN(b.x)], 1u);
            asm volatile("s_waitcnt vmcnt(0)" ::: "memory");
        } else {
            XB_SPIN(xb_ld(&bar[XB_XGEN(b.x)]) == gen, bar);
            __builtin_amdgcn_fence(__ATOMIC_ACQUIRE, "agent");
            asm volatile("s_waitcnt vmcnt(0)" ::: "memory");
        }
    }
    __syncthreads();
}

constexpr size_t WS_BAR = 64 * 1024;
#define GRID_SYNC() do { asm volatile("s_waitcnt vmcnt(0) lgkmcnt(0)" ::: "memory"); grid.sync(); } while (0)
struct Args { const void* in[18]; float* out; unsigned char* ws; };
__global__ void __launch_bounds__(NTHREADS) mk_fwd(Args a) {
    extern __shared__ __attribute__((aligned(16))) unsigned char lds[];
    cg::grid_group grid = cg::this_grid();
    const int tid = threadIdx.x, lane = tid & 63, wave = __builtin_amdgcn_readfirstlane(tid >> 6);
    const int G = gridDim.x, bx = blockIdx.x, vcu = (G % 8 == 0) ? (bx % 8) * (G / 8) + bx / 8 : bx;
    const int gw = vcu * NWAVES + wave, NGW = G * NWAVES;
    unsigned char* ws = a.ws; unsigned char* dob = (unsigned char*)a.out;
    const float* x = (const float*)a.in[0]; const float* cvec = (const float*)a.in[1]; const int* positions = (const int*)a.in[2];
    const float* w_ada = (const float*)a.in[3]; const float* b_ada = (const float*)a.in[4]; const float* w_in = (const float*)a.in[5];
    const float* b_gates = (const float*)a.in[6]; const float* q_norm_g = (const float*)a.in[7]; const float* w_q_b = (const float*)a.in[8];
    const float* kv_norm_g = (const float*)a.in[9]; const float* w_kv_b = (const float*)a.in[10]; const float* w_mla_o = (const float*)a.in[11];
    const float* w_pool_g = (const float*)a.in[12]; const float* pool_scale = (const float*)a.in[13]; const float* w_pool_o = (const float*)a.in[14];
    const float* w_out = (const float*)a.in[15]; const float* ln_g = (const float*)a.in[16]; const float* ln_b = (const float*)a.in[17];
    float* modv = (float*)(ws + WS_MOD);
    bf16_t* Wt_in = (bf16_t*)(ws + WS_WIN); bf16_t* Wt_kpe = (bf16_t*)(ws + WS_WKPE); bf16_t* Wt_qb = (bf16_t*)(ws + WS_WQB); bf16_t* Wt_kvb = (bf16_t*)(ws + WS_WKVB); bf16_t* Wt_mlao = (bf16_t*)(ws + WS_WMLAO);
    bf16_t* Wt_poolg = (bf16_t*)(ws + WS_WPOOLG); bf16_t* Wt_poolo = (bf16_t*)(ws + WS_WPOOLO); bf16_t* Wt_out = (bf16_t*)(ws + WS_WOUT);
    bf16_t* hbuf = (bf16_t*)(ws + WS_R1); bf16_t* Vb = (bf16_t*)(ws + WS_R1); bf16_t* zb = (bf16_t*)(ws + WS_R1);
    bf16_t* sgate = (bf16_t*)(ws + WS_SGATE); bf16_t* spgate = (bf16_t*)(ws + WS_SPGATE); bf16_t* gates = (bf16_t*)(ws + WS_GATES);
    float* lat = (float*)(ws + WS_LAT); float* pool_in = (float*)(ws + WS_POOLIN); bf16_t* Qb = (bf16_t*)(ws + WS_Q); bf16_t* pmix = (bf16_t*)(ws + WS_PMIX);
    bf16_t* kvn = (bf16_t*)(ws + WS_KVN); float* cs = (float*)(ws + WS_CS);
    bf16_t* Kn = (bf16_t*)(dob + DO_KN); bf16_t* Kp = (bf16_t*)(dob + DO_KP); bf16_t* pooled = (bf16_t*)(dob + DO_POOLED); bf16_t* qn = (bf16_t*)(dob + DO_QN);
    LAS unsigned char* ldsl = (LAS unsigned char*)lds;
    volatile LAS unsigned* bar_st = (volatile LAS unsigned*)(ldsl + 131072);
    if (tid < 2) bar_st[tid] = 0u;
    if (bx == 0) for (int u_ = tid; u_ < XCD_BAR_WORDS; u_ += NTHREADS) ((unsigned*)(ws + WS_BAR))[u_] = 0u;
    __syncthreads();


    for (int cb = bx; cb < 192; cb += G) {
        LAS f32x4* red = (LAS f32x4*)lds;
        const int c4 = tid & 7, rg = tid >> 3; f32x4 acc = {0.f, 0.f, 0.f, 0.f};
        const float* wp = w_ada + 32 * cb + 4 * c4;
#pragma unroll 8
        for (int d = rg; d < DM; d += 64) { const float cv = cvec[d]; const float sv = cv * pg8::sigmoid_f(cv); acc += *(const f32x4*)(wp + (size_t)d * (3 * DM)) * sv; }
        red[rg * 8 + c4] = acc;
        __syncthreads();
        if (tid < 32) { const LAS float* rf = (const LAS float*)lds; float s = 0.f;
            for (int r = 0; r < 64; ++r) s += rf[r * 32 + tid];
            modv[32 * cb + tid] = s + b_ada[32 * cb + tid]; }
        __syncthreads();
    }
    for (int e = bx * NTHREADS + tid; e < SEQ * 32; e += G * NTHREADS) {
        const int s = e >> 5, i = e & 31; const float inv_freq = exp2f(-(float)i * (13.287712379549449f / 32.f));
        const float ang = (float)positions[s] * inv_freq; float sn, cn; sincosf(ang, &sn, &cn);
        cs[2 * e] = cn; cs[2 * e + 1] = sn;
    }
    {
        LAS float* scr = (LAS float*)(ldsl + wave * 16384);
        constexpr int I_IN = (DM / 64) * (INW_MAIN / 32), I_KPE = (DM / 64) * (256 / 32);
        for (int it = gw; it < I_IN + I_KPE; it += NGW) { if (it < I_IN) transpose_item<1>(w_in, DM, INW, INW_MAIN, Wt_in, scr, it, lane); else transpose_item<4>(w_in, DM, INW, 256, Wt_kpe, scr, it - I_IN, lane); }
    }
    GRID_SYNC();
    const XcdBarrier xbar = xcd_barrier_post((unsigned*)(ws + WS_BAR), bar_st);

    for (int row = gw; row < SEQ; row += NGW) {
        const f32x4* xr = (const f32x4*)(x + (size_t)row * DM) + lane;
        f32x4 v[8]; float s = 0.f;
#pragma unroll
        for (int j = 0; j < 8; ++j) { v[j] = xr[64 * j]; s += (v[j][0] + v[j][1]) + (v[j][2] + v[j][3]); }
        const float mean = wave_sum(s) * (1.f / DM); float s2 = 0.f;
#pragma unroll
        for (int j = 0; j < 8; ++j) { v[j] = v[j] - mean; s2 += (v[j][0] * v[j][0] + v[j][1] * v[j][1]) + (v[j][2] * v[j][2] + v[j][3] * v[j][3]); }
        const float rstd = 1.f / sqrtf(wave_sum(s2) * (1.f / DM) + LN_EPS);
        u32x2* o8 = (u32x2*)(hbuf + (size_t)row * DM) + lane;
#pragma unroll
        for (int j = 0; j < 8; ++j) { const f32x4 sh = *((const f32x4*)modv + lane + 64 * j), sc = *((const f32x4*)(modv + DM) + lane + 64 * j);
            const f32x4 y = v[j] * rstd * (sc + 1.f) + sh; u32x2 w; w.x = pk2(y[0], y[1]); w.y = pk2(y[2], y[3]); o8[64 * j] = w; }
    }
    xcd_barrier(xbar);

    {
        pg8::Gemm g{hbuf, Wt_in, SEQ, INW_MAIN, DM}; pg8::StaticOrder S; S.init(SEQ, INW_MAIN, G, bx);
        pg8::EpiIn E{lat, sgate, pool_in, spgate, gates, b_gates};
        pg8::gemm_phase<pg8::EpiIn, pg8::StaticOrder, true, true>(ldsl, g, S, E);
    }
    xcd_barrier(xbar);

    const bool split15 = (G == 256);
    if (!split15 || bx < 64) {
        pg8::Gemm g{hbuf, Wt_kpe, SEQ, 256, DM}; pg8::KpeOrder S{G, bx};
        pg8::EpiKpe E{Kp, cs};
        pg8::gemm_phase<pg8::EpiKpe, pg8::KpeOrder, true, true>(ldsl, g, S, E);
    }
    if (!split15 || bx >= 64) {
        LAS float* scr = (LAS float*)(ldsl + wave * 16384);
        constexpr int I_QB = (QLR / 64) * (3072 / 32), I_KVB = (KVLR / 64) * (4096 / 32), I_MLAO = (MLAW / 64) * (DM / 32),
                      I_PG = (256 / 64) * (256 / 32), I_PO = (POOLW / 64) * (DM / 32), I_OUT = (DM / 64) * (DM / 32);
        constexpr int NITEMS = I_QB + I_KVB + I_MLAO + 4 * I_PG + I_PO + I_OUT;
        const int w0 = (G == 256 ? (bx - 64) : bx) * NWAVES + wave, nw = (G == 256 ? (G - 64) : G) * NWAVES;
        for (int it = w0; it < NITEMS; it += nw) {
            int r = it;
            if (r < I_QB) { transpose_item<2>(w_q_b, QLR, 3072, 3072, Wt_qb, scr, r, lane); continue; } r -= I_QB;
            if (r < I_KVB) { transpose_item<3>(w_kv_b, KVLR, 4096, 4096, Wt_kvb, scr, r, lane); continue; } r -= I_KVB;
            if (r < I_MLAO) { transpose_item<0>(w_mla_o, MLAW, DM, DM, Wt_mlao, scr, r, lane); continue; } r -= I_MLAO;
            if (r < 4 * I_PG) { const int g = r / I_PG; transpose_item<0>(w_pool_g + (size_t)g * 65536, 256, 256, 256, Wt_poolg + (size_t)g * 65536, scr, r % I_PG, lane); continue; } r -= 4 * I_PG;
            if (r < I_PO) { transpose_item<0>(w_pool_o, POOLW, DM, DM, Wt_poolo, scr, r, lane); continue; } r -= I_PO;
            transpose_item<0>(w_out, DM, DM, DM, Wt_out, scr, r, lane);
        }
    const int rw0 = split15 ? (bx - 64) * NWAVES + wave : gw, rnw = split15 ? (G - 64) * NWAVES : NGW;
    for (int row = rw0; row < SEQ; row += rnw) {
        const float* lr = lat + (size_t)row * LATW;
#pragma unroll
        for (int part = 0; part < 2; ++part) {
            const f32x4* p = (const f32x4*)(lr + part * 512) + lane; const f32x4 a0 = p[0], a1 = p[64];
            const float ss = wave_sum((a0[0] * a0[0] + a0[1] * a0[1]) + (a0[2] * a0[2] + a0[3] * a0[3]) + (a1[0] * a1[0] + a1[1] * a1[1]) + (a1[2] * a1[2] + a1[3] * a1[3]));
            const float r = 1.f / sqrtf(ss * (1.f / 512.f) + RMS_EPS);
            const f32x4* gp = (const f32x4*)(part ? kv_norm_g : q_norm_g) + lane; const f32x4 g0 = gp[0], g1 = gp[64];
            u32x2* o = (u32x2*)((part ? kvn : qn) + (size_t)row * 512) + lane;
            const f32x4 y0 = a0 * r * g0, y1 = a1 * r * g1; u32x2 w0, w1; w0.x = pk2(y0[0], y0[1]); w0.y = pk2(y0[2], y0[3]); w1.x = pk2(y1[0], y1[1]); w1.y = pk2(y1[2], y1[3]);
            o[0] = w0; o[64] = w1;
        }
#pragma unroll
        for (int g = 0; g < 4; ++g) {
            const int wlen = 2 << g, cnt = (row + 1 < wlen) ? row + 1 : wlen;
            const f32x4* up = (const f32x4*)(pool_in + (size_t)row * POOLW + 256 * g) + lane; const f32x4 u0 = *up; f32x4 sum = u0;
            for (int j = 1; j < cnt; ++j) sum += *(up - (size_t)j * (POOLW / 4));
            const f32x4 pv = sum * (1.f / (float)cnt) - u0; u32x2 w; w.x = pk2(pv[0], pv[1]); w.y = pk2(pv[2], pv[3]);
            *((u32x2*)(pooled + ((size_t)g * SEQ + row) * 256) + lane) = w;
        }
    }
    }
    xcd_barrier(xbar);

    {
        pg8::Gemm g{qn, Wt_qb, SEQ, 3072, QLR}; pg8::StaticOrder S; S.init(SEQ, 3072, G, bx);
        pg8::EpiQ E{Qb, cs};
        pg8::gemm_phase<pg8::EpiQ, pg8::StaticOrder, true, true>(ldsl, g, S, E);
    }
    {
        pg8::Gemm g{kvn, Wt_kvb, SEQ, 4096, KVLR}; pg8::StaticOrder S; S.init(SEQ, 4096, G, bx);
        pg8::EpiKV E{Kn, Vb};
        pg8::gemm_phase<pg8::EpiKV, pg8::StaticOrder, true, true>(ldsl, g, S, E);
    }
    {
        int kpool = 256; asm volatile("" : "+s"(kpool));
        pg8::Gemm g{pooled, Wt_poolg, 4 * SEQ, 256, kpool}; pg8::PoolOrder S{G, bx};
        pg8::EpiPool E{pmix, spgate, pool_scale};
        pg8::gemm_phase<pg8::EpiPool, pg8::PoolOrder, true, true>(ldsl, g, S, E);
    }
    xcd_barrier(xbar);

    {
        const att::Tensors T{Qb, Kn, Kp, Vb, sgate};
        att::attn_phase((char*)lds, T, vcu, G);
    }
    xcd_barrier(xbar);

    {
    {
        pg8::Gemm g{sgate, Wt_mlao, SEQ, DM, MLAW}; pg8::StaticOrder S; S.init(SEQ, DM, G, bx);
        pg8::EpiMlaO E{zb, gates};
        pg8::gemm_phase<pg8::EpiMlaO, pg8::StaticOrder, true, true>(ldsl, g, S, E);
    }
    {
        pg8::Gemm g{pmix, Wt_poolo, SEQ, DM, POOLW}; pg8::StaticOrder S; S.init(SEQ, DM, G, bx);
        pg8::EpiPoolO E{zb, gates};
        pg8::gemm_phase<pg8::EpiPoolO, pg8::StaticOrder, true, true>(ldsl, g, S, E);
    }
    }
    xcd_barrier(xbar);

    {
        pg8::Gemm g{zb, Wt_out, SEQ, DM, DM}; pg8::StaticOrder S; S.init(SEQ, DM, G, bx);
        pg8::EpiOut E{a.out, x, modv};
        pg8::gemm_phase<pg8::EpiOut, pg8::StaticOrder, true, true>(ldsl, g, S, E);
    }
    xcd_barrier(xbar);

    for (int row = gw; row < SEQ; row += NGW) {
        f32x4* xr = (f32x4*)(a.out + (size_t)row * DM) + lane;
        f32x4 v[8]; float s = 0.f;
#pragma unroll
        for (int j = 0; j < 8; ++j) { v[j] = xr[64 * j]; s += (v[j][0] + v[j][1]) + (v[j][2] + v[j][3]); }
        const float mean = wave_sum(s) * (1.f / DM); float s2 = 0.f;
#pragma unroll
        for (int j = 0; j < 8; ++j) { v[j] = v[j] - mean; s2 += (v[j][0] * v[j][0] + v[j][1] * v[j][1]) + (v[j][2] * v[j][2] + v[j][3] * v[j][3]); }
        const float rstd = 1.f / sqrtf(wave_sum(s2) * (1.f / DM) + LN_EPS);
#pragma unroll
        for (int j = 0; j < 8; ++j) { const f32x4 gg = *((const f32x4*)ln_g + lane + 64 * j), bb = *((const f32x4*)ln_b + lane + 64 * j);
            xr[64 * j] = v[j] * rstd * gg + bb; }

    }
}

extern "C" void kernel_launch(void* const* d_in, const int* in_sizes, int n_in, void* d_out, int out_size, void* d_ws, size_t ws_size, hipStream_t stream) {
    static int grid_blocks = 0;
    if (grid_blocks == 0) {
        if (n_in != 18 || out_size != SEQ * DM || ws_size < WS_END) { fprintf(stderr, "kernel_launch: unexpected shapes (n_in %d out %d ws %zu)\n", n_in, out_size, ws_size); grid_blocks = -1; return; }
        int dev = 0, cus = 0, per_cu = 0;
        (void)hipGetDevice(&dev); (void)hipDeviceGetAttribute(&cus, hipDeviceAttributeMultiprocessorCount, dev);
        if (hipFuncSetAttribute((const void*)mk_fwd, hipFuncAttributeMaxDynamicSharedMemorySize, LDS_BYTES) != hipSuccess) { fprintf(stderr, "kernel_launch: hipFuncSetAttribute failed\n"); grid_blocks = -1; return; }
        if (hipOccupancyMaxActiveBlocksPerMultiprocessor(&per_cu, (const void*)mk_fwd, NTHREADS, LDS_BYTES) != hipSuccess || per_cu < 1) per_cu = 1;
        (void)hipGetLastError();
        grid_blocks = cus * per_cu;
    }
    if (grid_blocks < 0) return;
    Args a{};
    for (int i = 0; i < 18; ++i) a.in[i] = d_in[i];
    a.out = (float*)d_out; a.ws = (unsigned char*)d_ws;
    void* args[] = {&a};
    hipError_t e = hipLaunchCooperativeKernel((const void*)mk_fwd, dim3(grid_blocks), dim3(NTHREADS), args, LDS_BYTES, stream);
    if (e != hipSuccess) fprintf(stderr, "cooperative launch failed: %s (grid %d)\n", hipGetErrorString(e), grid_blocks);
}
```

```cpp
#include <hip/hip_runtime.h>
#include <hip/hip_cooperative_groups.h>
#include <cstdio>
#include <cstdint>
namespace cg = cooperative_groups;
namespace pg8 {
#define PG8_LAS __attribute__((address_space(3)))
typedef unsigned short bf16_t;
typedef short bf16x8 __attribute__((ext_vector_type(8)));
typedef float f32x4 __attribute__((ext_vector_type(4)));
typedef unsigned u32x4 __attribute__((ext_vector_type(4)));
constexpr int BM = 256, BK = 64, HALF = 128, HTB = HALF * BK * 2  , STAGE_BYTES = 8 * HTB, NXCD = 8, WGM = 8;

__host__ __device__ __forceinline__ int lds_byte(int r, int c) { const int st = (r >> 4) * 2 + (c >> 5), rr = r & 15, cc = c & 31, ob = rr * 64 + cc * 2; return st * 1024 + (ob ^ (((ob >> 9) & 1) << 5)); }
__host__ __device__ __forceinline__ void stage_rc(int b, int& R, int& C) { const int st = b / 1024, sb = b % 1024, swz = sb ^ (((sb >> 9) & 1) << 5); R = (st >> 1) * 16 + swz / 64; C = (st & 1) * 32 + (swz % 64) / 2; }
__host__ __device__ __forceinline__ int perm32(int rho) { const int n = rho >> 4, i = rho & 15; return 8 * (i >> 2) + 4 * n + (i & 3); }

struct Unit { int pm, pn; };
struct Gemm { const bf16_t* A; const bf16_t* Bt; int M, N, K; };

struct StaticOrder {
    int nM, nN, nwg, G, c;
    __host__ __device__ void init(int M, int N, int G_, int c_) { nM = M / BM; nN = N / BM; nwg = nM * nN; G = G_; c = c_; }
    __host__ __device__ bool next(int i, Unit& u) const {
        const long L = (long)i * G + c; if (L >= nwg) return false;
        int wgid = (int)L; { const int q = nwg / NXCD, r = nwg % NXCD, xcd = wgid % NXCD, off = wgid / NXCD; wgid = (xcd < r ? xcd * (q + 1) : r * (q + 1) + (xcd - r) * q) + off; }
        const int nig = WGM * nN, gid = wgid / nig, fm = gid * WGM, gsz = (nM - fm) < WGM ? (nM - fm) : WGM;
        u.pm = fm + ((wgid % nig) % gsz); u.pn = (wgid % nig) / gsz; return true;
    }
    __device__ __forceinline__ void a_ready(const Unit&) const {}
    __device__ __forceinline__ void done(const Unit&) const {}
};

typedef float f32x2c __attribute__((ext_vector_type(2)));
typedef __bf16 bf16x2c __attribute__((ext_vector_type(2)));
__device__ __forceinline__ unsigned cvt_pk_bf16(float lo, float hi) { const f32x2c v = {lo, hi}; return __builtin_bit_cast(unsigned, __builtin_convertvector(v, bf16x2c)); }
template <class Epi, class Sched, bool ALIGN_EPI = false, bool SP2 = false>
__device__ __forceinline__ void gemm_phase(PG8_LAS unsigned char* lds, const Gemm g, const Sched& S, const Epi& E) {
    int tid_ = threadIdx.x; asm volatile("" : "+v"(tid_));
    const int tid = tid_, wid = __builtin_amdgcn_readfirstlane(tid >> 6), lane = tid & 63, wr = wid >> 2, wc = wid & 3, fr = lane & 15, fq = lane >> 4;
    const int K = g.K, nt = K / BK;
    unsigned voffA[2], voffB[2];
#pragma unroll
    for (int i = 0; i < 2; ++i) { int R, C; stage_rc(tid * 16 + i * 8192, R, C); const int Rb = Epi::PERM ? ((R & ~31) + perm32(R & 31)) : R;
        voffA[i] = (unsigned)(R * K + C) * 2u; voffB[i] = (unsigned)(Rb * K + C) * 2u; }
    const size_t kstep = (size_t)(BK * 2);
    const size_t hstep = (size_t)HALF * K * 2;
    const size_t tstep = 2 * hstep;
    const unsigned ldsw = (unsigned)wid * 1024u;
    const int aoff = lds_byte(wr * 64 + fr, fq * 8), boff = lds_byte(wc * 32 + fr, fq * 8);
#define PG8_SA(b, h) (((b) * 2 + (h)) * HTB)
#define PG8_SB(b, h) ((4 + (b) * 2 + (h)) * HTB)
#define PG8_STAGE(bufoff, gbase, voff) do { _Pragma("unroll") for (int _i = 0; _i < 2; ++_i) \
        __builtin_amdgcn_global_load_lds((const unsigned*)((const char*)(gbase) + (voff)[_i]), (PG8_LAS unsigned*)(lds + (bufoff) + ldsw + _i * 8192), 16, 0, 0); } while (0)
#define PG8_LDA(dst, b, h) do { _Pragma("unroll") for (int m = 0; m < 4; ++m) _Pragma("unroll") for (int k = 0; k < 2; ++k) dst[m][k] = *(const PG8_LAS bf16x8*)(lds + PG8_SA(b, h) + aoff + m * 2048 + k * 1024); } while (0)
#define PG8_LDB(dst, b, h) do { _Pragma("unroll") for (int n = 0; n < 2; ++n) _Pragma("unroll") for (int k = 0; k < 2; ++k) dst[n][k] = *(const PG8_LAS bf16x8*)(lds + PG8_SB(b, h) + boff + n * 2048 + k * 1024); } while (0)
#define PG8_MMA(ai, bj, At, Bt) do { __builtin_amdgcn_s_setprio(1); _Pragma("unroll") for (int m = 0; m < 4; ++m) _Pragma("unroll") for (int n = 0; n < 2; ++n) _Pragma("unroll") for (int k = 0; k < 2; ++k) \
        acc[ai][bj][m][n] = __builtin_amdgcn_mfma_f32_16x16x32_bf16(Bt[n][k], At[m][k], acc[ai][bj][m][n], 0, 0, 0); __builtin_amdgcn_s_setprio(0); } while (0)
#define PG8_WAIT_V(n) asm volatile("s_waitcnt vmcnt(" #n ")" ::: "memory")
#define PG8_WAIT_L(n) asm volatile("s_waitcnt lgkmcnt(" #n ")" ::: "memory")
#define PG8_BAR __builtin_amdgcn_s_barrier()
#define PG8_SCHED __builtin_amdgcn_sched_barrier(0)
    Unit cur, nxt; int ui = 0;
    if (!S.next(0, cur)) return;
    f32x4 acc[2][2][4][2];
#pragma unroll
    for (int a = 0; a < 2; ++a)
#pragma unroll
        for (int b = 0; b < 2; ++b)
#pragma unroll
            for (int m = 0; m < 4; ++m)
#pragma unroll
                for (int n = 0; n < 2; ++n) acc[a][b][m][n] = (f32x4){0.f, 0.f, 0.f, 0.f};
    bf16x8 At[4][2], B0[2][2], B1[2][2];
    const char* cA = (const char*)g.A + (size_t)cur.pm * tstep; const char* cB = (const char*)g.Bt + (size_t)cur.pn * tstep;
    S.a_ready(cur);
    if constexpr (SP2) {
        PG8_STAGE(PG8_SB(0, 0), cB, voffB); PG8_STAGE(PG8_SB(0, 1), cB + hstep, voffB); PG8_STAGE(PG8_SA(0, 0), cA, voffA); PG8_STAGE(PG8_SA(0, 1), cA + hstep, voffA);
        if (wr == 1) PG8_BAR;
        PG8_WAIT_V(2); PG8_BAR;
        PG8_STAGE(PG8_SB(1, 0), cB + kstep, voffB); PG8_STAGE(PG8_SA(1, 0), cA + kstep, voffA); PG8_STAGE(PG8_SB(1, 1), cB + hstep + kstep, voffB);
        PG8_WAIT_V(6); PG8_BAR;
    } else {
        PG8_STAGE(PG8_SB(0, 0), cB, voffB); PG8_STAGE(PG8_SA(0, 0), cA, voffA); PG8_STAGE(PG8_SB(0, 1), cB + hstep, voffB); PG8_STAGE(PG8_SA(0, 1), cA + hstep, voffA);
        if (wr == 1) PG8_BAR;
        PG8_WAIT_V(4); PG8_BAR;
        PG8_STAGE(PG8_SB(1, 0), cB + kstep, voffB); PG8_STAGE(PG8_SA(1, 0), cA + kstep, voffA); PG8_STAGE(PG8_SB(1, 1), cB + hstep + kstep, voffB);
        PG8_WAIT_V(6); PG8_BAR;
    }
    for (;;) {
        const bool has_next = S.next(ui + 1, nxt);
        const char* nA = has_next ? (const char*)g.A + (size_t)nxt.pm * tstep : cA; const char* nB = has_next ? (const char*)g.Bt + (size_t)nxt.pn * tstep : cB;
        for (int t = 0; t < nt; t += 2) {
            const bool last = (t == nt - 2);
            const char* a1 = cA + (size_t)(t + 1) * kstep;
            const char* a2 = last ? nA : cA + (size_t)(t + 2) * kstep; const char* b2 = last ? nB : cB + (size_t)(t + 2) * kstep;
            const char* a3 = a2 + kstep; const char* b3 = b2 + kstep;
            if (last && has_next) S.a_ready(nxt);
            if constexpr (SP2) {
            PG8_LDB(B0, 0, 0); PG8_LDB(B1, 0, 1); PG8_SCHED; PG8_LDA(At, 0, 0); PG8_STAGE(PG8_SA(1, 1), a1 + hstep, voffA);
            PG8_WAIT_V(8); PG8_WAIT_L(0); PG8_BAR; PG8_MMA(0, 0, At, B0); PG8_MMA(0, 1, At, B1); PG8_BAR; PG8_SCHED;
            PG8_LDA(At, 0, 1); PG8_STAGE(PG8_SB(0, 0), b2, voffB); PG8_STAGE(PG8_SB(0, 1), b2 + hstep, voffB); PG8_STAGE(PG8_SA(0, 0), a2, voffA);
            PG8_WAIT_V(8); PG8_WAIT_L(0); PG8_BAR; PG8_MMA(1, 0, At, B0); PG8_MMA(1, 1, At, B1); PG8_BAR; PG8_SCHED;
            PG8_LDB(B0, 1, 0); PG8_LDB(B1, 1, 1); PG8_SCHED; PG8_LDA(At, 1, 0); PG8_STAGE(PG8_SA(0, 1), a2 + hstep, voffA);
            PG8_WAIT_V(8); PG8_WAIT_L(0); PG8_BAR; PG8_MMA(0, 0, At, B0); PG8_MMA(0, 1, At, B1); PG8_BAR; PG8_SCHED;
            PG8_LDA(At, 1, 1); PG8_STAGE(PG8_SB(1, 0), b3, voffB); PG8_STAGE(PG8_SB(1, 1), b3 + hstep, voffB); PG8_STAGE(PG8_SA(1, 0), a3, voffA);
            PG8_WAIT_V(8); PG8_WAIT_L(0); PG8_BAR; PG8_MMA(1, 0, At, B0); PG8_MMA(1, 1, At, B1); PG8_BAR; PG8_SCHED;
            } else {
            PG8_LDB(B0, 0, 0); PG8_SCHED; PG8_LDA(At, 0, 0); PG8_STAGE(PG8_SA(1, 1), a1 + hstep, voffA);
            PG8_WAIT_L(8); PG8_BAR; PG8_WAIT_L(0); PG8_MMA(0, 0, At, B0); PG8_BAR; PG8_SCHED;
            PG8_LDB(B1, 0, 1); PG8_STAGE(PG8_SB(0, 0), b2, voffB);
            PG8_BAR; PG8_WAIT_L(0); PG8_MMA(0, 1, At, B1); PG8_BAR;
            PG8_LDA(At, 0, 1); PG8_STAGE(PG8_SA(0, 0), a2, voffA);
            PG8_BAR; PG8_WAIT_L(0); PG8_MMA(1, 0, At, B0); PG8_BAR; PG8_SCHED;
            PG8_STAGE(PG8_SB(0, 1), b2 + hstep, voffB);
            PG8_WAIT_V(6); PG8_BAR; PG8_MMA(1, 1, At, B1); PG8_BAR;
            PG8_LDB(B0, 1, 0); PG8_SCHED; PG8_LDA(At, 1, 0); PG8_STAGE(PG8_SA(0, 1), a2 + hstep, voffA);
            PG8_WAIT_L(8); PG8_BAR; PG8_WAIT_L(0); PG8_MMA(0, 0, At, B0); PG8_BAR; PG8_SCHED;
            PG8_LDB(B1, 1, 1); PG8_STAGE(PG8_SB(1, 0), b3, voffB);
            PG8_BAR; PG8_WAIT_L(0); PG8_MMA(0, 1, At, B1); PG8_BAR;
            PG8_LDA(At, 1, 1); PG8_STAGE(PG8_SA(1, 0), a3, voffA);
            PG8_BAR; PG8_WAIT_L(0); PG8_MMA(1, 0, At, B0); PG8_BAR; PG8_SCHED;
            PG8_STAGE(PG8_SB(1, 1), b3 + hstep, voffB);
            PG8_WAIT_V(6); PG8_BAR; PG8_MMA(1, 1, At, B1); PG8_BAR;
            }
        }
        if constexpr (ALIGN_EPI) { if (wr == 0) PG8_BAR; }
        if constexpr (!Epi::AFTER_DRAIN) { E(acc, cur, wr, wc, fr, fq); S.done(cur); }
        if (!has_next) break;
#pragma unroll
        for (int a = 0; a < 2; ++a)
#pragma unroll
            for (int b = 0; b < 2; ++b)
#pragma unroll
                for (int m = 0; m < 4; ++m)
#pragma unroll
                    for (int n = 0; n < 2; ++n) acc[a][b][m][n] = (f32x4){0.f, 0.f, 0.f, 0.f};
        cur = nxt; cA = nA; cB = nB; ++ui;
        if constexpr (ALIGN_EPI) { if (wr == 1) PG8_BAR; }
    }
    PG8_WAIT_V(0);
    if constexpr (!ALIGN_EPI) { if (wr == 0) PG8_BAR; }
    PG8_BAR;
    if constexpr (Epi::AFTER_DRAIN) { E.fused(acc, cur, wr, wc, fr, fq, lds, wid, lane); S.done(cur); }
#undef PG8_SA
#undef PG8_SB
#undef PG8_STAGE
#undef PG8_LDA
#undef PG8_LDB
#undef PG8_MMA
#undef PG8_WAIT_V
#undef PG8_WAIT_L
#undef PG8_BAR
#undef PG8_SCHED
}
}

constexpr int SEQ = 16384, DM = 2048, NH = 16, DQK = 192, DNOPE = 128, DROPE = 64, DV = 128;
constexpr int QLR = 512, KVLR = 512, MLAW = 2048, POOLW = 1024, INW = 9280, INW_PAD = 9472, LATW = 1088;
constexpr float RMS_EPS = 1e-6f, LN_EPS = 1e-5f;
constexpr float DN_ALPHA = 1.189207115002721f;

namespace pg8 {
typedef unsigned u32x2 __attribute__((ext_vector_type(2)));
__device__ __forceinline__ u32x4 pack8(f32x4 a, f32x4 b) { u32x4 w; w.x = cvt_pk_bf16(a[0], a[1]); w.y = cvt_pk_bf16(a[2], a[3]); w.z = cvt_pk_bf16(b[0], b[1]); w.w = cvt_pk_bf16(b[2], b[3]); return w; }
__device__ __forceinline__ float bf_lo(unsigned w) { return __uint_as_float(w << 16); }
__device__ __forceinline__ float bf_hi(unsigned w) { return __uint_as_float(w & 0xffff0000u); }
__device__ __forceinline__ void unpack8(u32x4 w, f32x4& a, f32x4& b) { a = (f32x4){bf_lo(w.x), bf_hi(w.x), bf_lo(w.y), bf_hi(w.y)}; b = (f32x4){bf_lo(w.z), bf_hi(w.z), bf_lo(w.w), bf_hi(w.w)}; }
__device__ __forceinline__ float sigmoid_f(float v) { return __builtin_amdgcn_rcpf(1.f + __expf(-v)); }
__device__ __forceinline__ f32x4 sigmoid4(f32x4 v) { return (f32x4){sigmoid_f(v[0]), sigmoid_f(v[1]), sigmoid_f(v[2]), sigmoid_f(v[3])}; }
__device__ __forceinline__ f32x4 silu4(f32x4 v) { return v * sigmoid4(v); }

#define EPI_FOR(ai, m, bj) _Pragma("unroll") for (int ai = 0; ai < 2; ++ai) _Pragma("unroll") for (int m = 0; m < 4; ++m) _Pragma("unroll") for (int bj = 0; bj < 2; ++bj)
#define EPI_ROWB(ai, m, LD, ES) ((size_t)((ai) * HALF + (m) * 16) * (LD) * (ES))
#define EPI_FENCE(bj) do { if ((bj) == 1) asm volatile("" ::: "memory"); } while (0)

struct EpiIn {
    static constexpr bool PERM = true, AFTER_DRAIN = false;
    float* lat; bf16_t* sgate; float* pool_in; bf16_t* spgate; bf16_t* gates; const float* b_gates;
    __device__ __forceinline__ void operator()(const f32x4 (&acc)[2][2][4][2], const Unit& u, int wr, int wc, int fr, int fq) const {
        const int pn = u.pn, rowu = u.pm * BM + wr * 64, colu = wc * 32;
        if (pn < 5) {
            const unsigned lo = (unsigned)(fr * LATW + 8 * fq) * 4u; char* ub = (char*)lat + ((size_t)rowu * LATW + pn * BM + colu) * 4;
            EPI_FOR(ai, m, bj) { if (pn < 4 || (bj == 0 && wc < 2)) { char* p = ub + EPI_ROWB(ai, m, LATW, 4) + bj * (HALF * 4) + lo;
                *(f32x4*)p = acc[ai][bj][m][0]; *(f32x4*)(p + 16) = acc[ai][bj][m][1]; } }
        } else if (pn < 13) {
            const unsigned lo = (unsigned)(fr * MLAW + 8 * fq) * 2u; char* ub = (char*)sgate + ((size_t)rowu * MLAW + (pn - 5) * BM + colu) * 2;
            EPI_FOR(ai, m, bj) { *(u32x4*)(ub + EPI_ROWB(ai, m, MLAW, 2) + bj * (HALF * 2) + lo) = pack8(silu4(acc[ai][bj][m][0]), silu4(acc[ai][bj][m][1])); }
        } else if (pn < 17) {
            const unsigned lo = (unsigned)(fr * POOLW + 8 * fq) * 4u; char* ub = (char*)pool_in + ((size_t)rowu * POOLW + (pn - 13) * BM + colu) * 4;
            EPI_FOR(ai, m, bj) { char* p = ub + EPI_ROWB(ai, m, POOLW, 4) + bj * (HALF * 4) + lo; *(f32x4*)p = acc[ai][bj][m][0]; *(f32x4*)(p + 16) = acc[ai][bj][m][1]; }
        } else if (pn < 21) {
            const unsigned lo = (unsigned)(fr * POOLW + 8 * fq) * 2u; char* ub = (char*)spgate + ((size_t)rowu * POOLW + (pn - 17) * BM + colu) * 2;
            EPI_FOR(ai, m, bj) { *(u32x4*)(ub + EPI_ROWB(ai, m, POOLW, 2) + bj * (HALF * 2) + lo) = pack8(silu4(acc[ai][bj][m][0]), silu4(acc[ai][bj][m][1])); }
        } else {
            f32x4 bv[2][2];
#pragma unroll
            for (int bj = 0; bj < 2; ++bj) { const float* bp = b_gates + (pn - 21) * BM + bj * HALF + colu + 8 * fq; bv[bj][0] = *(const f32x4*)bp; bv[bj][1] = *(const f32x4*)(bp + 4); }
            const unsigned lo = (unsigned)(fr * (2 * DM) + 8 * fq) * 2u; char* ub = (char*)gates + ((size_t)rowu * (2 * DM) + (pn - 21) * BM + colu) * 2;
            EPI_FOR(ai, m, bj) { *(u32x4*)(ub + EPI_ROWB(ai, m, 2 * DM, 2) + bj * (HALF * 2) + lo) = pack8(sigmoid4(acc[ai][bj][m][0] + bv[bj][0]), sigmoid4(acc[ai][bj][m][1] + bv[bj][1])); }
        }
    }
};
struct EpiQ {
    static constexpr bool PERM = true, AFTER_DRAIN = false;
    bf16_t* Q; const float* cs;
    __device__ __forceinline__ void operator()(const f32x4 (&acc)[2][2][4][2], const Unit& u, int wr, int wc, int fr, int fq) const {
        const int pn = u.pn, rowu = u.pm * BM + wr * 64;
        const unsigned lo = (unsigned)(fr * DQK + 8 * fq) * 2u;
        if (pn < 8) {
            char* ub = (char*)Q + (((size_t)(pn * 2) * SEQ + rowu) * DQK + wc * 32) * 2;
            EPI_FOR(ai, m, bj) { *(u32x4*)(ub + EPI_ROWB(ai, m, DQK, 2) + (size_t)bj * ((size_t)SEQ * DQK * 2) + lo) = pack8(acc[ai][bj][m][0], acc[ai][bj][m][1]); }
        } else {
            const int h0 = (pn - 8) * 4 + (wc >> 1), ju = (wc & 1) * 32;
            char* ub = (char*)Q + (((size_t)h0 * SEQ + rowu) * DQK + DNOPE + ju) * 2;
            const unsigned lc = (unsigned)(fr * 64 + 8 * fq) * 4u; const char* cb = (const char*)cs + ((size_t)rowu * 64 + ju) * 4;
            _Pragma("unroll") for (int ai = 0; ai < 2; ++ai) { f32x4 tv[4][2];
                _Pragma("unroll") for (int m = 0; m < 4; ++m) { const char* cp = cb + EPI_ROWB(ai, m, 64, 4) + lc; tv[m][0] = *(const f32x4*)cp; tv[m][1] = *(const f32x4*)(cp + 16); }
                asm volatile("" ::: "memory");
                _Pragma("unroll") for (int m = 0; m < 4; ++m) _Pragma("unroll") for (int bj = 0; bj < 2; ++bj) { const f32x4 t0 = tv[m][0], t1 = tv[m][1];
                    const f32x4 c = (f32x4){t0[0], t0[2], t1[0], t1[2]}, s = (f32x4){t0[1], t0[3], t1[1], t1[3]};
                    const f32x4 x1 = acc[ai][bj][m][0], x2 = acc[ai][bj][m][1];
                    *(u32x4*)(ub + EPI_ROWB(ai, m, DQK, 2) + (size_t)bj * ((size_t)2 * SEQ * DQK * 2) + lo) = pack8(x1 * c - x2 * s, x1 * s + x2 * c); }
                asm volatile("" ::: "memory"); }
        }
    }
};
struct EpiKV {
    static constexpr bool PERM = true, AFTER_DRAIN = false;
    bf16_t* Kn; bf16_t* V;
    __device__ __forceinline__ void operator()(const f32x4 (&acc)[2][2][4][2], const Unit& u, int wr, int wc, int fr, int fq) const {
        const int pn = u.pn, rowu = u.pm * BM + wr * 64;
        const unsigned lo = (unsigned)(fr * 128 + 8 * fq) * 2u;
        char* ub = (char*)(pn < 8 ? Kn : V) + (((size_t)((pn & 7) * 2) * SEQ + rowu) * 128 + wc * 32) * 2;
        EPI_FOR(ai, m, bj) { *(u32x4*)(ub + EPI_ROWB(ai, m, 128, 2) + (size_t)bj * ((size_t)SEQ * 128 * 2) + lo) = pack8(acc[ai][bj][m][0], acc[ai][bj][m][1]); }
    }
};
#define EPI_HALF(ai) _Pragma("unroll") for (int ai = 0; ai < 2; ++ai)
#define EPI_MB(m, bj) _Pragma("unroll") for (int m = 0; m < 4; ++m) _Pragma("unroll") for (int bj = 0; bj < 2; ++bj)
#define EPI_MEMFENCE() asm volatile("" ::: "memory")
struct EpiPool {
    static constexpr bool PERM = true, AFTER_DRAIN = false;
    bf16_t* pmix; const bf16_t* spgate; const float* pool_scale;
    __device__ __forceinline__ void operator()(const f32x4 (&acc)[2][2][4][2], const Unit& u, int wr, int wc, int fr, int fq) const {
        const int g = u.pn, rowu = (u.pm & 63) * BM + wr * 64, colu = g * 256 + wc * 32;
        f32x4 sv[2][2];
#pragma unroll
        for (int bj = 0; bj < 2; ++bj) { const float* sp = pool_scale + colu + bj * HALF + 8 * fq; sv[bj][0] = *(const f32x4*)sp; sv[bj][1] = *(const f32x4*)(sp + 4); }
        const unsigned lo = (unsigned)(fr * POOLW + 8 * fq) * 2u; const size_t uo = ((size_t)rowu * POOLW + colu) * 2;
        EPI_HALF(ai) { u32x4 gw[4][2];
            EPI_MB(m, bj) gw[m][bj] = *(const u32x4*)((const char*)spgate + uo + EPI_ROWB(ai, m, POOLW, 2) + bj * (HALF * 2) + lo);
            EPI_MEMFENCE();
            EPI_MB(m, bj) { f32x4 g0, g1; unpack8(gw[m][bj], g0, g1);
                *(u32x4*)((char*)pmix + uo + EPI_ROWB(ai, m, POOLW, 2) + bj * (HALF * 2) + lo) = pack8(acc[ai][bj][m][0] * sv[bj][0] * g0, acc[ai][bj][m][1] * sv[bj][1] * g1); }
            EPI_MEMFENCE(); }
    }
};
struct EpiMlaO {
    static constexpr bool PERM = true, AFTER_DRAIN = false;
    bf16_t* z; const bf16_t* gates;
    __device__ __forceinline__ void operator()(const f32x4 (&acc)[2][2][4][2], const Unit& u, int wr, int wc, int fr, int fq) const {
        const int rowu = u.pm * BM + wr * 64, colu = u.pn * BM + wc * 32;
        const unsigned loz = (unsigned)(fr * DM + 8 * fq) * 2u, log_ = (unsigned)(fr * (2 * DM) + 8 * fq) * 2u;
        char* zb_ = (char*)z + ((size_t)rowu * DM + colu) * 2; const char* gb_ = (const char*)gates + ((size_t)rowu * (2 * DM) + colu) * 2;
        EPI_HALF(ai) { u32x4 gw[4][2];
            EPI_MB(m, bj) gw[m][bj] = *(const u32x4*)(gb_ + EPI_ROWB(ai, m, 2 * DM, 2) + bj * (HALF * 2) + log_);
            EPI_MEMFENCE();
            EPI_MB(m, bj) { f32x4 g0, g1; unpack8(gw[m][bj], g0, g1);
                *(u32x4*)(zb_ + EPI_ROWB(ai, m, DM, 2) + bj * (HALF * 2) + loz) = pack8(acc[ai][bj][m][0] * g0, acc[ai][bj][m][1] * g1); }
            EPI_MEMFENCE(); }
    }
};
struct EpiPoolO {
    static constexpr bool PERM = true, AFTER_DRAIN = false;
    bf16_t* z; const bf16_t* gates;
    __device__ __forceinline__ void operator()(const f32x4 (&acc)[2][2][4][2], const Unit& u, int wr, int wc, int fr, int fq) const {
        const int rowu = u.pm * BM + wr * 64, colu = u.pn * BM + wc * 32;
        const unsigned loz = (unsigned)(fr * DM + 8 * fq) * 2u, log_ = (unsigned)(fr * (2 * DM) + 8 * fq) * 2u;
        char* zb_ = (char*)z + ((size_t)rowu * DM + colu) * 2; const char* gb_ = (const char*)gates + ((size_t)rowu * (2 * DM) + DM + colu) * 2;
        EPI_HALF(ai) { u32x4 gw[4][2], zw[4][2];
            EPI_MB(m, bj) { gw[m][bj] = *(const u32x4*)(gb_ + EPI_ROWB(ai, m, 2 * DM, 2) + bj * (HALF * 2) + log_); zw[m][bj] = *(const u32x4*)(zb_ + EPI_ROWB(ai, m, DM, 2) + bj * (HALF * 2) + loz); }
            EPI_MEMFENCE();
            EPI_MB(m, bj) { f32x4 g0, g1, z0, z1; unpack8(gw[m][bj], g0, g1); unpack8(zw[m][bj], z0, z1);
                *(u32x4*)(zb_ + EPI_ROWB(ai, m, DM, 2) + bj * (HALF * 2) + loz) = pack8(z0 + acc[ai][bj][m][0] * g0, z1 + acc[ai][bj][m][1] * g1); }
            EPI_MEMFENCE(); }
    }
};
struct EpiOut {
    static constexpr bool PERM = true, AFTER_DRAIN = false;
    float* out; const float* x; const float* mod;
    __device__ __forceinline__ void operator()(const f32x4 (&acc)[2][2][4][2], const Unit& u, int wr, int wc, int fr, int fq) const {
        const int rowu = u.pm * BM + wr * 64, colu = u.pn * BM + wc * 32;
        f32x4 gv[2][2];
#pragma unroll
        for (int bj = 0; bj < 2; ++bj) { const float* gp = mod + 2 * DM + bj * HALF + colu + 8 * fq; gv[bj][0] = *(const f32x4*)gp + 1.f; gv[bj][1] = *(const f32x4*)(gp + 4) + 1.f; }
        const unsigned lo = (unsigned)(fr * DM + 8 * fq) * 4u; const size_t uo = ((size_t)rowu * DM + colu) * 4;
        EPI_HALF(ai) { f32x4 xv[4][2][2];
            EPI_MB(m, bj) { const char* xp = (const char*)x + uo + EPI_ROWB(ai, m, DM, 4) + bj * (HALF * 4) + lo; xv[m][bj][0] = *(const f32x4*)xp; xv[m][bj][1] = *(const f32x4*)(xp + 16); }
            EPI_MEMFENCE();
            EPI_MB(m, bj) { char* op = (char*)out + uo + EPI_ROWB(ai, m, DM, 4) + bj * (HALF * 4) + lo;
                *(f32x4*)op = xv[m][bj][0] * DN_ALPHA + gv[bj][0] * acc[ai][bj][m][0]; *(f32x4*)(op + 16) = xv[m][bj][1] * DN_ALPHA + gv[bj][1] * acc[ai][bj][m][1]; }
            EPI_MEMFENCE(); }
    }
};
struct PoolOrder {
    int G, c;
    __device__ bool next(int i, Unit& u) const { const int L = i * G + c; if (L >= 256) return false; u.pm = L; u.pn = L >> 6; return true; }
    __device__ __forceinline__ void a_ready(const Unit&) const {}
    __device__ __forceinline__ void done(const Unit&) const {}
};
}

namespace att {
typedef unsigned short bf16;
typedef short bf16x8 __attribute__((ext_vector_type(8)));
typedef short s16x4 __attribute__((ext_vector_type(4)));
typedef float f32x16 __attribute__((ext_vector_type(16)));
typedef float f32x4 __attribute__((ext_vector_type(4)));
typedef unsigned u32x4 __attribute__((ext_vector_type(4)));
constexpr int NW = 8, QBLK = 32, KVBLK = 64, QB = NW * QBLK, NQB = SEQ / QB;
constexpr int SHM_V = KVBLK * DV * 2, SHM_K = KVBLK * DQK * 2;
constexpr int NVB = 3;
constexpr int LDS_BYTES = NVB * SHM_V + 2 * SHM_K + NW * 64 * 4;
constexpr float SCALE = 0.07216878364870322f;
constexpr float THR = 8.f;
constexpr int OPITCH = MLAW;

#define KSWZ(row, colB) ((row) * 384 + ((colB) ^ ((((row) >> 1) & 7) << 4)))
#define SBAR() __builtin_amdgcn_sched_barrier(0)
__device__ __forceinline__ int v_st(int k, int c) { const int kk = (k & ~0xC) | ((k & 4) << 1) | ((k & 8) >> 1); return ((kk >> 3) * 4 + (c >> 5)) * 512 + ((kk & 7) * 32 + (c & 31)) * 2; }
__device__ __forceinline__ int v_rd_base(int lane) { return ((lane & 3) << 3) | (((lane >> 2) & 3) << 6) | (((lane >> 4) & 1) << 5) | (((lane >> 5) & 1) << 8); }
constexpr int v_rd_off(int d0, int ks, int half) { return d0 * 512 + ks * 4096 + half * 2048; }
__device__ __forceinline__ int crow(int r, int hi) { return (r & 3) + 8 * (r >> 2) + 4 * hi; }
__device__ __forceinline__ unsigned cvtpk(float lo, float hi) { return pg8::cvt_pk_bf16(lo, hi); }
__device__ __forceinline__ bf16x8 ld8(const bf16* p) { return *reinterpret_cast<const bf16x8*>(p); }
__device__ __forceinline__ void mask_tile(f32x16& p0, f32x16& p1, int dq) {
    const float NEG = -__builtin_inff();
#pragma unroll
    for (int r = 0; r < 16; ++r) { const int c = (r & 3) + 8 * (r >> 2);
        if (dq - c < 0) p0[r] = NEG;
        if (dq - c - 32 < 0) p1[r] = NEG; }
}
__device__ __forceinline__ void partialSM(f32x16& p0, f32x16& p1, float& m_reg, float& mn, float& alpha) {
    float pmax = p0[0]; for (int r = 1; r < 16; ++r) pmax = fmaxf(pmax, p0[r]); for (int r = 0; r < 16; ++r) pmax = fmaxf(pmax, p1[r]);
    { auto rr = __builtin_amdgcn_permlane32_swap(__float_as_uint(pmax), __float_as_uint(pmax), false, false);
      pmax = fmaxf(__uint_as_float(rr[0]), __uint_as_float(rr[1])); }
    constexpr float C2 = 1.4426950408889634f * SCALE;
    if (__builtin_expect(__all((pmax - m_reg) * SCALE <= THR), 1)) { mn = m_reg; alpha = 1.f; }
    else { mn = fmaxf(m_reg, pmax); alpha = __builtin_amdgcn_exp2f((m_reg - mn) * C2); m_reg = mn; }
    const float mnL = -mn * C2;
    for (int r = 0; r < 16; ++r) p0[r] = fmaf(p0[r], C2, mnL); for (int r = 0; r < 16; ++r) p1[r] = fmaf(p1[r], C2, mnL);
    for (int r = 0; r < 16; ++r) p0[r] = __builtin_amdgcn_exp2f(p0[r]);
}
__device__ __forceinline__ void finishSM(f32x16& p0, f32x16& p1, float alpha, float& l_reg, bf16x8& pa0, bf16x8& pa1, bf16x8& pa2, bf16x8& pa3) {
    for (int r = 0; r < 16; ++r) p1[r] = __builtin_amdgcn_exp2f(p1[r]);
    float ps = 0; for (int r = 0; r < 16; ++r) ps += p0[r]; for (int r = 0; r < 16; ++r) ps += p1[r];
    { auto rr = __builtin_amdgcn_permlane32_swap(__float_as_uint(ps), __float_as_uint(ps), false, false);
      ps = __uint_as_float(rr[0]) + __uint_as_float(rr[1]); }
    l_reg = l_reg * alpha + ps;
#define PK4(P, B_, OUT) do { unsigned a0 = cvtpk(P[B_+0], P[B_+1]), a1 = cvtpk(P[B_+2], P[B_+3]);                          \
        unsigned b0 = cvtpk(P[B_+4], P[B_+5]), b1 = cvtpk(P[B_+6], P[B_+7]);                                             \
        auto r0 = __builtin_amdgcn_permlane32_swap(a0, b0, false, false); auto r1 = __builtin_amdgcn_permlane32_swap(a1, b1, false, false); \
        u32x4 w = {r0[0], r1[0], r0[1], r1[1]}; OUT = *reinterpret_cast<bf16x8*>(&w); } while (0)
    PK4(p0, 0, pa0); PK4(p0, 8, pa1); PK4(p1, 0, pa2); PK4(p1, 8, pa3);
#undef PK4
}
template <int KB>
__device__ __forceinline__ void qkt(f32x16& p0, f32x16& p1, const char* K_lds, int r32, int hi, const bf16x8* qr) {
    p0 = f32x16{}; p1 = f32x16{};
    const char* kb[4];
#pragma unroll
    for (int dd = 0; dd < 4; ++dd) kb[dd] = K_lds + KB * SHM_K + KSWZ(r32, (dd * 16 + hi * 8) * 2);
#pragma unroll
    for (int d0 = 0; d0 < 12; ++d0) { const char* a = kb[d0 & 3] + (d0 >> 2) * 128;
        bf16x8 b0 = *reinterpret_cast<const bf16x8*>(a);
        bf16x8 b1 = *reinterpret_cast<const bf16x8*>(a + 32 * 384);
        p0 = __builtin_amdgcn_mfma_f32_32x32x16_bf16(b0, qr[d0], p0, 0, 0, 0);
        p1 = __builtin_amdgcn_mfma_f32_32x32x16_bf16(b1, qr[d0], p1, 0, 0, 0); }
}
template <int VB>
__device__ __forceinline__ void pv_tile(f32x16* o, int vb0, bf16x8 pa0, bf16x8 pa1, bf16x8 pa2, bf16x8 pa3) {
#define TRRD(dst, off) asm volatile("ds_read_b64_tr_b16 %0, %1 offset:%2" : "=&v"(dst) : "v"(vb0), "i"(off) : "memory")
#define PV_D0(d0) do { s16x4 l0, l1, l2, l3, h0, h1, h2, h3; constexpr int b_ = VB * SHM_V + v_rd_off(d0, 0, 0); \
        TRRD(l0, b_); TRRD(h0, b_ + 2048); TRRD(l1, b_ + 4096); TRRD(h1, b_ + 6144); TRRD(l2, b_ + 8192); TRRD(h2, b_ + 10240); TRRD(l3, b_ + 12288); TRRD(h3, b_ + 14336); \
        asm volatile("s_waitcnt lgkmcnt(0)" ::: "memory"); SBAR();   \
        o[d0] = __builtin_amdgcn_mfma_f32_32x32x16_bf16(pa0, (bf16x8){l0[0], l0[1], l0[2], l0[3], h0[0], h0[1], h0[2], h0[3]}, o[d0], 0, 0, 0);   \
        o[d0] = __builtin_amdgcn_mfma_f32_32x32x16_bf16(pa1, (bf16x8){l1[0], l1[1], l1[2], l1[3], h1[0], h1[1], h1[2], h1[3]}, o[d0], 0, 0, 0);   \
        o[d0] = __builtin_amdgcn_mfma_f32_32x32x16_bf16(pa2, (bf16x8){l2[0], l2[1], l2[2], l2[3], h2[0], h2[1], h2[2], h2[3]}, o[d0], 0, 0, 0);   \
        o[d0] = __builtin_amdgcn_mfma_f32_32x32x16_bf16(pa3, (bf16x8){l3[0], l3[1], l3[2], l3[3], h3[0], h3[1], h3[2], h3[3]}, o[d0], 0, 0, 0); } while (0)
    PV_D0(0); PV_D0(1); PV_D0(2); PV_D0(3);
#undef PV_D0
#undef TRRD
}
#ifndef DRY_NOSM
#define DRY_NOSM 0
#endif
#ifndef DRY_NOSTAGE
#define DRY_NOSTAGE 0
#endif
#ifndef DRY_WRAP
#define DRY_WRAP 0
#endif
__device__ __forceinline__ void cheapSM(f32x16& p0, f32x16& p1, float& l_reg, bf16x8& pa0, bf16x8& pa1, bf16x8& pa2, bf16x8& pa3) {
    l_reg += fabsf(p0[0]) + fabsf(p1[0]);
#define PK4(P, B_, OUT) do { unsigned a0 = cvtpk(P[B_+0], P[B_+1]), a1 = cvtpk(P[B_+2], P[B_+3]);                          \
        unsigned b0 = cvtpk(P[B_+4], P[B_+5]), b1 = cvtpk(P[B_+6], P[B_+7]);                                             \
        auto r0 = __builtin_amdgcn_permlane32_swap(a0, b0, false, false); auto r1 = __builtin_amdgcn_permlane32_swap(a1, b1, false, false); \
        u32x4 w = {r0[0], r1[0], r0[1], r1[1]}; OUT = *reinterpret_cast<bf16x8*>(&w); } while (0)
    PK4(p0, 0, pa0); PK4(p0, 8, pa1); PK4(p1, 0, pa2); PK4(p1, 8, pa3);
#undef PK4
}
struct BlockRef { const bf16* Q; const bf16* Kn; const bf16* Kp; const bf16* V; bf16* O; int P0; };
#define VMW() asm volatile("s_waitcnt vmcnt(0)" ::: "memory")
typedef __attribute__((address_space(3))) unsigned lds_u32;
#define STAGE(kbf, vbf, k0) do {                                                                                                                 \
        _Pragma("unroll") for (int i_ = 0; i_ < 2; ++i_) __builtin_amdgcn_global_load_lds((const unsigned*)(pV[i_] + (size_t)(k0) * (DV * 2)),    \
            (lds_u32*)(uintptr_t)(ldsV + (vbf) * SHM_V + (wid * 2 + i_) * 1024), 16, 0, 0);                                                      \
        _Pragma("unroll") for (int i_ = 0; i_ < 3; ++i_) __builtin_amdgcn_global_load_lds((const unsigned*)(pK[i_] + (size_t)(k0) * stK[i_]),     \
            (lds_u32*)(uintptr_t)(ldsK + (kbf) * SHM_K + (wid * 3 + i_) * 1024), 16, 0, 0); } while (0)
__device__ __forceinline__ void attn_block(const BlockRef& cur, char* lds, bool rev, bool dry = false) {
    int tid_ = threadIdx.x; asm volatile("" : "+v"(tid_));
    const int tid = tid_, wid = __builtin_amdgcn_readfirstlane(tid >> 6), lane = tid & 63, r32 = lane & 31, hi = lane >> 5;
    const int NT = cur.P0 / KVBLK + QB / KVBLK;
    const int qlo = cur.P0 + wid * QBLK, qm = qlo + r32 - 4 * hi;
    char* V_lds = lds; char* K_lds = lds + NVB * SHM_V;
    float* ws = (float*)(lds + NVB * SHM_V + 2 * SHM_K) + wid * 64; float* li_l = ws, * al_l = ws + 32;
    const int vb0 = (int)(uintptr_t)V_lds + v_rd_base(lane);
    const unsigned ldsV = (unsigned)(uintptr_t)V_lds, ldsK = (unsigned)(uintptr_t)K_lds;
    const unsigned lo_q = (unsigned)(r32 * DQK + hi * 8) * 2u, lo_o = (unsigned)(hi * 4 * OPITCH + (r32 & ~1)) * 2u;
    const char* pK[3]; unsigned stK[3]; const char* pV[2];
#pragma unroll
    for (int i = 0; i < 3; ++i) { const int o_ = (wid * 3 + i) * 1024 + lane * 16, r = o_ / 384, s = (o_ % 384) / 16, c = (s & ~7) | ((s ^ (r >> 1)) & 7);
        if (c < 16) { pK[i] = (const char*)cur.Kn + (r * DNOPE + c * 8) * 2; stK[i] = DNOPE * 2; } else { pK[i] = (const char*)cur.Kp + (r * DROPE + (c - 16) * 8) * 2; stK[i] = DROPE * 2; } }
#pragma unroll
    for (int i = 0; i < 2; ++i) { const int o_ = (wid * 2 + i) * 1024 + lane * 16, st = o_ / 512, w2 = (o_ % 512) / 2, kk = (st / 4) * 8 + w2 / 32, c = (st % 4) * 32 + (w2 % 32);
        const int k = (kk & ~0xC) | ((kk & 4) << 1) | ((kk & 8) >> 1); pV[i] = (const char*)cur.V + (k * DV + c) * 2; }
    bf16x8 qr[12];
    { const char* qb_ = (const char*)cur.Q + (size_t)wid * (QBLK * DQK * 2);
#pragma unroll
      for (int d0 = 0; d0 < 12; ++d0) qr[d0] = *(const bf16x8*)(qb_ + lo_q + d0 * 32); }
    const bool grpB = wid >= 4;
#define TILE_KB(t) ((rev ? NT - 1 - (t) : (t)) * KVBLK)
    STAGE(0, 0, TILE_KB(0)); VMW();
    __syncthreads();
    float m_reg = -1e30f, l_reg = 0; f32x16 o[4] = {};
#define RESC(a) do { if (__any((a) < 1.f)) { if (hi == 0) al_l[r32] = (a); asm volatile("s_waitcnt lgkmcnt(0)" ::: "memory");              \
                     for (int d_ = 0; d_ < 4; ++d_) for (int r = 0; r < 16; ++r) o[d_][r] *= al_l[crow(r, hi)]; } } while (0)
#define SM_PV(tt, vslot) do { const int kq_ = TILE_KB(tt);                                                                    \
        if (kq_ + KVBLK - 1 > qlo) mask_tile(p0, p1, qm - kq_);                                                               \
        float mn, al = 1.f; bf16x8 pa0, pa1, pa2, pa3;                                                                         \
        if (DRY_NOSM && dry) { cheapSM(p0, p1, l_reg, pa0, pa1, pa2, pa3); } else { partialSM(p0, p1, m_reg, mn, al); finishSM(p0, p1, al, l_reg, pa0, pa1, pa2, pa3); } \
        RESC(al); SBAR();                                                                                                     \
        pv_tile<0>(o, vb0 + (vslot) * SHM_V, pa0, pa1, pa2, pa3); } while (0)
    if (!grpB) {
        int vs = 0;
        for (int t = 0; t <= NT; ++t) { const int kbuf = t & 1, vn = vs == 2 ? 0 : vs + 1;
            if (t + 1 < NT && !(DRY_NOSTAGE && dry)) STAGE(kbuf ^ 1, vn, TILE_KB(t + 1));
            if (t < NT) { f32x16 p0, p1; SBAR(); qkt<0>(p0, p1, K_lds + kbuf * SHM_K, r32, hi, qr); SM_PV(t, vs); }
            VMW(); __syncthreads();
            vs = vn; }
    } else {
        int vs = 0; f32x16 p0, p1;
        if (!(DRY_NOSTAGE && dry)) STAGE(1, 1, TILE_KB(1));
        SBAR(); qkt<0>(p0, p1, K_lds, r32, hi, qr);
        VMW(); __syncthreads();
        vs = 1;
        for (int t = 1; t <= NT; ++t) { const int kbuf = t & 1, vn = vs == 2 ? 0 : vs + 1, vp = vs == 0 ? 2 : vs - 1;
            if (t + 1 < NT && !(DRY_NOSTAGE && dry)) STAGE(kbuf ^ 1, vn, TILE_KB(t + 1));
            SM_PV(t - 1, vp);
            if (t < NT) { SBAR(); qkt<0>(p0, p1, K_lds + kbuf * SHM_K, r32, hi, qr); }
            VMW(); __syncthreads();
            vs = vn; }
    }
#undef SM_PV
#undef TILE_KB
#undef STEP
#undef RESC
    if (hi == 0) li_l[r32] = l_reg; asm volatile("s_waitcnt lgkmcnt(0)" ::: "memory");
    char* ob_ = (char*)cur.O + (size_t)wid * (QBLK * OPITCH * 2);
    unsigned gw[16][4];
#pragma unroll
    for (int r = 0; r < 16; ++r) { const unsigned* gp = (const unsigned*)(ob_ + (size_t)((r & 3) + 8 * (r >> 2)) * (OPITCH * 2) + lo_o);
#pragma unroll
        for (int d0 = 0; d0 < 4; ++d0) gw[r][d0] = gp[d0 * 16]; }
    asm volatile("" ::: "memory");
#pragma unroll
    for (int r = 0; r < 16; ++r) { const float rli = __builtin_amdgcn_rcpf(li_l[crow(r, hi)]);
        unsigned* gp = (unsigned*)(ob_ + (size_t)((r & 3) + 8 * (r >> 2)) * (OPITCH * 2) + lo_o);
#pragma unroll
        for (int d0 = 0; d0 < 4; ++d0) { const float v = o[d0][r] * rli; const float vn = __shfl_xor(v, 1);
            if ((r32 & 1) == 0 && (!dry || l_reg < 0.f)) gp[d0 * 16] = cvtpk(v * __uint_as_float(gw[r][d0] << 16), vn * __uint_as_float(gw[r][d0] & 0xffff0000u)); } }
    __syncthreads();
}
#undef VMW
#undef STAGE
struct Tensors { const bf16* Q; const bf16* Kn; const bf16* Kp; const bf16* V; bf16* O; };
__device__ __forceinline__ BlockRef mk_ref(const Tensors& T, int L, int pass) {
    const int h = L >> 5, x = L & 31, qb = pass ? x : (NQB - 1 - x); BlockRef r;
    r.Q = T.Q + ((size_t)h * SEQ + (size_t)qb * QB) * DQK; r.Kn = T.Kn + (size_t)h * SEQ * DNOPE; r.Kp = T.Kp; r.V = T.V + (size_t)h * SEQ * DV;
    r.O = T.O + (size_t)qb * QB * OPITCH + h * DV; r.P0 = qb * QB; return r;
}
__device__ __forceinline__ void attn_phase(char* lds, const Tensors& T, int first, int stride, bool dry = false) {
    constexpr int total = NH * (NQB / 2);
    for (int L = first; L < total; L += stride)
        for (int pass = 0; pass < 2; ++pass) { const BlockRef cur = mk_ref(T, L, pass); attn_block(cur, lds, pass != 0, dry); }
}
#undef KSWZ
#undef SBAR
}

constexpr int NWAVES = 8, NTHREADS = NWAVES * 64;
constexpr int LDS_BYTES = 131072 + 1024;
constexpr size_t MiB = 1u << 20;
constexpr size_t WS_MOD = 0;
constexpr size_t WS_WIN = 1 * MiB, WS_WQB = 38 * MiB, WS_WKVB = 41 * MiB, WS_WMLAO = 45 * MiB, WS_WPOOLG = 53 * MiB, WS_WPOOLO = 54 * MiB, WS_WOUT = 58 * MiB;
constexpr size_t WS_R1 = 66 * MiB;
constexpr size_t WS_SGATE = 130 * MiB;
constexpr size_t WS_SPGATE = 194 * MiB;
constexpr size_t WS_GATES = 226 * MiB;
constexpr size_t WS_LAT = 354 * MiB;
constexpr size_t WS_POOLIN = 422 * MiB;
constexpr size_t WS_Q = 354 * MiB;
constexpr size_t WS_PMIX = 450 * MiB;
constexpr size_t WS_KVN = 486 * MiB;
constexpr size_t WS_CS = 502 * MiB;
constexpr size_t WS_END = 506 * MiB;
constexpr size_t DO_KN = 0, DO_KP = 64 * MiB, DO_POOLED = 66 * MiB, DO_QN = 98 * MiB;
static_assert(WS_LAT + (size_t)SEQ * LATW * 4 <= WS_POOLIN && WS_Q + (size_t)NH * SEQ * DQK * 2 <= WS_PMIX && WS_PMIX + (size_t)SEQ * POOLW * 2 <= WS_KVN && WS_CS + (size_t)SEQ * 64 * 4 <= WS_END, "ws map");
static_assert(WS_WIN + (size_t)INW_PAD * DM * 2 <= WS_WQB && WS_WOUT + (size_t)DM * DM * 2 <= WS_R1 && DO_QN + (size_t)SEQ * QLR * 2 <= 128 * MiB, "ws map 2");

#define LAS __attribute__((address_space(3)))
typedef unsigned short bf16_t;
typedef float f32x4 __attribute__((ext_vector_type(4)));
typedef unsigned u32x4 __attribute__((ext_vector_type(4)));
typedef unsigned u32x2 __attribute__((ext_vector_type(2)));
__device__ __forceinline__ unsigned pk2(float lo, float hi) { return pg8::cvt_pk_bf16(lo, hi); }
__device__ __forceinline__ float wave_sum(float v) {
#pragma unroll
    for (int o = 1; o < 64; o <<= 1) v += __shfl_xor(v, o);
    return v;
}
__device__ __forceinline__ int ropeperm(int j) { const int blk = j >> 3, w = j & 7; return (w < 4) ? 4 * blk + w : 32 + 4 * blk + (w - 4); }
template <int MAP> __device__ __forceinline__ int src_col(int r) {
    if (MAP == 1) { if (r < 1024) return r; if (r < 1088) return 1024 + ropeperm(r - 1024); if (r < 1280) return -1; return r - 192; }
    if (MAP == 2) { if (r < 2048) return (r >> 7) * DQK + (r & 127); const int q = r - 2048; return (q >> 6) * DQK + DNOPE + ropeperm(q & 63); }
    if (MAP == 3) { if (r < 2048) return (r >> 7) * 256 + (r & 127); const int q = r - 2048; return (q >> 7) * 256 + 128 + (q & 127); }
    return r;
}
template <int MAP> __device__ __forceinline__ void transpose_item(const float* W, int K, int Nsrc, int Ndst, bf16_t* WT, LAS float* scr, int item, int lane) {
    const int nblk = Ndst / 32, kb = item / nblk, nb = item % nblk, k0 = 64 * kb, n0 = 32 * nb;
    const int sc = src_col<MAP>(n0 + (lane & 31));
    float tv_[32];
#pragma unroll
    for (int i = 0; i < 32; ++i) { const int kk = 2 * i + (lane >> 5); tv_[i] = sc >= 0 ? W[(size_t)(k0 + kk) * Nsrc + sc] : 0.f; }
#pragma unroll
    for (int i = 0; i < 32; ++i) { const int kk = 2 * i + (lane >> 5); scr[kk * 33 + (lane & 31)] = tv_[i]; }
    asm volatile("s_waitcnt lgkmcnt(0)" ::: "memory");
    const int c = lane & 7;
#pragma unroll
    for (int j = 0; j < 4; ++j) { const int n = (lane >> 3) + 8 * j; const LAS float* s = scr + (8 * c) * 33 + n;
        u32x4 o; o.x = pk2(s[0 * 33], s[1 * 33]); o.y = pk2(s[2 * 33], s[3 * 33]); o.z = pk2(s[4 * 33], s[5 * 33]); o.w = pk2(s[6 * 33], s[7 * 33]);
        *(u32x4*)(WT + (size_t)(n0 + n) * K + k0 + 8 * c) = o; }
    asm volatile("s_waitcnt lgkmcnt(0)" ::: "memory");
}

#define XB_TMO      128
#define XB_XCNT(j)  (256  + 64 * (j))
#define XB_XSUB(j)  (1280 + 64 * (j))
#define XB_XGEN(j)  (2304 + 64 * (j))
#define XB_TOP      3328
#define XB_TOPGEN   3392
#define XCD_BAR_WORDS 3456
#define XB_SPIN_CAP (1u << 18)

__device__ __forceinline__ unsigned xb_ld(unsigned* p)              { return __hip_atomic_load(p, __ATOMIC_RELAXED, __HIP_MEMORY_SCOPE_AGENT); }
__device__ __forceinline__ unsigned xb_add(unsigned* p, unsigned v) { return __hip_atomic_fetch_add(p, v, __ATOMIC_RELAXED, __HIP_MEMORY_SCOPE_AGENT); }
__device__ __forceinline__ unsigned xb_xcc_id() { return (unsigned)__builtin_amdgcn_s_getreg((3 << 11) | 20) & 0xFu; }
#define XB_SPIN(cond, bar) do { unsigned _sp = 0; while (cond) { __builtin_amdgcn_s_sleep(1); \
    if ((++_sp & 255u) == 0u) { if (xb_ld(&(bar)[XB_TMO])) break; if (_sp > XB_SPIN_CAP) { atomicAdd(&(bar)[XB_TMO], 1u); break; } } } } while (0)

struct XcdBarrier {
    unsigned* bar; unsigned x;
    volatile LAS unsigned* st;
};

__device__ __forceinline__ XcdBarrier xcd_barrier_post(unsigned* bar, volatile LAS unsigned* st) {
    XcdBarrier b; b.bar = bar; b.x = xb_xcc_id(); b.st = st;
    if (threadIdx.x == 0) (void)xb_add(&bar[XB_XCNT(b.x)], 1u);
    return b;
}
__device__ __forceinline__ void xcd_barrier_complete(unsigned* bar, unsigned x, unsigned& nloc, unsigned& nx) {
    const unsigned G = gridDim.x * gridDim.y * gridDim.z;
    unsigned sum, cnt, mine, sp = 0u;
    for (;;) {
        sum = 0u; cnt = 0u; mine = 0u;
#pragma unroll
        for (unsigned j = 0; j < 16; ++j) { const unsigned c = xb_ld(&bar[XB_XCNT(j)]); sum += c; cnt += (c > 0u) ? 1u : 0u; mine = (j == x) ? c : mine; }
        if (sum == G) break;
        __builtin_amdgcn_s_sleep(1);
        if ((++sp & 255u) == 0u) { if (xb_ld(&bar[XB_TMO])) break; if (sp > XB_SPIN_CAP) { atomicAdd(&bar[XB_TMO], 1u); break; } }
    }
    nloc = mine > 0u ? mine : 1u; nx = cnt > 0u ? cnt : 1u;
}

__device__ __forceinline__ void xcd_barrier(const XcdBarrier& b) {
    asm volatile("s_waitcnt vmcnt(0)" ::: "memory");
    __syncthreads();
    if (threadIdx.x == 0) {
        unsigned* bar = b.bar;
        __builtin_amdgcn_s_waitcnt(0);
        unsigned nloc = b.st[0], nx = b.st[1];
        if (nloc == 0u) { xcd_barrier_complete(bar, b.x, nloc, nx); b.st[0] = nloc; b.st[1] = nx; }
        const unsigned old = xb_add(&bar[XB_XSUB(b.x)], 1u);
        const unsigned gen = old / nloc;
        if (old + 1u == (gen + 1u) * nloc) {
            __builtin_amdgcn_fence(__ATOMIC_RELEASE, "agent");
            asm volatile("s_waitcnt vmcnt(0)" ::: "memory");
            const unsigned og = xb_add(&bar[XB_TOP], 1u);
            const unsigned tg = og / nx;
            if (og + 1u == (tg + 1u) * nx) xb_add(&bar[XB_TOPGEN], 1u);
            else XB_SPIN(xb_ld(&bar[XB_TOPGEN]) == tg, bar);
            __builtin_amdgcn_fence(__ATOMIC_ACQUIRE, "agent");
            xb_add(&bar[XB_XGEN(b.x)], 1u);
            asm volatile("s_waitcnt vmcnt(0)" ::: "memory");
        } else {
            XB_SPIN(xb_ld(&bar[XB_XGEN(b.x)]) == gen, bar);
            __builtin_amdgcn_fence(__ATOMIC_ACQUIRE, "agent");
            asm volatile("s_waitcnt vmcnt(0)" ::: "memory");
        }
    }
    __syncthreads();
}

constexpr size_t WS_BAR = 64 * 1024;
#define GRID_SYNC() do { asm volatile("s_waitcnt vmcnt(0) lgkmcnt(0)" ::: "memory"); grid.sync(); } while (0)
struct Args { const void* in[18]; float* out; unsigned char* ws; };
__global__ void __launch_bounds__(NTHREADS) mk_fwd(Args a) {
    extern __shared__ __attribute__((aligned(16))) unsigned char lds[];
    cg::grid_group grid = cg::this_grid();
    const int tid = threadIdx.x, lane = tid & 63, wave = __builtin_amdgcn_readfirstlane(tid >> 6);
    const int G = gridDim.x, bx = blockIdx.x, vcu = (G % 8 == 0) ? (bx % 8) * (G / 8) + bx / 8 : bx;
    const int gw = vcu * NWAVES + wave, NGW = G * NWAVES;
    unsigned char* ws = a.ws; unsigned char* dob = (unsigned char*)a.out;
    const float* x = (const float*)a.in[0]; const float* cvec = (const float*)a.in[1]; const int* positions = (const int*)a.in[2];
    const float* w_ada = (const float*)a.in[3]; const float* b_ada = (const float*)a.in[4]; const float* w_in = (const float*)a.in[5];
    const float* b_gates = (const float*)a.in[6]; const float* q_norm_g = (const float*)a.in[7]; const float* w_q_b = (const float*)a.in[8];
    const float* kv_norm_g = (const float*)a.in[9]; const float* w_kv_b = (const float*)a.in[10]; const float* w_mla_o = (const float*)a.in[11];
    const float* w_pool_g = (const float*)a.in[12]; const float* pool_scale = (const float*)a.in[13]; const float* w_pool_o = (const float*)a.in[14];
    const float* w_out = (const float*)a.in[15]; const float* ln_g = (const float*)a.in[16]; const float* ln_b = (const float*)a.in[17];
    float* modv = (float*)(ws + WS_MOD);
    bf16_t* Wt_in = (bf16_t*)(ws + WS_WIN); bf16_t* Wt_qb = (bf16_t*)(ws + WS_WQB); bf16_t* Wt_kvb = (bf16_t*)(ws + WS_WKVB); bf16_t* Wt_mlao = (bf16_t*)(ws + WS_WMLAO);
    bf16_t* Wt_poolg = (bf16_t*)(ws + WS_WPOOLG); bf16_t* Wt_poolo = (bf16_t*)(ws + WS_WPOOLO); bf16_t* Wt_out = (bf16_t*)(ws + WS_WOUT);
    bf16_t* hbuf = (bf16_t*)(ws + WS_R1); bf16_t* Vb = (bf16_t*)(ws + WS_R1); bf16_t* zb = (bf16_t*)(ws + WS_R1);
    bf16_t* sgate = (bf16_t*)(ws + WS_SGATE); bf16_t* spgate = (bf16_t*)(ws + WS_SPGATE); bf16_t* gates = (bf16_t*)(ws + WS_GATES);
    float* lat = (float*)(ws + WS_LAT); float* pool_in = (float*)(ws + WS_POOLIN); bf16_t* Qb = (bf16_t*)(ws + WS_Q); bf16_t* pmix = (bf16_t*)(ws + WS_PMIX);
    bf16_t* kvn = (bf16_t*)(ws + WS_KVN); float* cs = (float*)(ws + WS_CS);
    bf16_t* Kn = (bf16_t*)(dob + DO_KN); bf16_t* Kp = (bf16_t*)(dob + DO_KP); bf16_t* pooled = (bf16_t*)(dob + DO_POOLED); bf16_t* qn = (bf16_t*)(dob + DO_QN);
    LAS unsigned char* ldsl = (LAS unsigned char*)lds;
    volatile LAS unsigned* bar_st = (volatile LAS unsigned*)(ldsl + 131072);
    if (tid < 2) bar_st[tid] = 0u;
    if (bx == 0) for (int u_ = tid; u_ < XCD_BAR_WORDS; u_ += NTHREADS) ((unsigned*)(ws + WS_BAR))[u_] = 0u;
    __syncthreads();


    for (int cb = bx; cb < 192; cb += G) {
        LAS f32x4* red = (LAS f32x4*)lds;
        const int c4 = tid & 7, rg = tid >> 3; f32x4 acc = {0.f, 0.f, 0.f, 0.f};
        const float* wp = w_ada + 32 * cb + 4 * c4;
#pragma unroll 8
        for (int d = rg; d < DM; d += 64) { const float cv = cvec[d]; const float sv = cv * pg8::sigmoid_f(cv); acc += *(const f32x4*)(wp + (size_t)d * (3 * DM)) * sv; }
        red[rg * 8 + c4] = acc;
        __syncthreads();
        if (tid < 32) { const LAS float* rf = (const LAS float*)lds; float s = 0.f;
            for (int r = 0; r < 64; ++r) s += rf[r * 32 + tid];
            modv[32 * cb + tid] = s + b_ada[32 * cb + tid]; }
        __syncthreads();
    }
    for (int e = bx * NTHREADS + tid; e < SEQ * 32; e += G * NTHREADS) {
        const int s = e >> 5, i = e & 31; const float inv_freq = exp2f(-(float)i * (13.287712379549449f / 32.f));
        const float ang = (float)positions[s] * inv_freq; float sn, cn; sincosf(ang, &sn, &cn);
        cs[2 * e] = cn; cs[2 * e + 1] = sn;
    }
    {
        LAS float* scr = (LAS float*)(ldsl + wave * 16384);
        constexpr int I_IN = (DM / 64) * (INW_PAD / 32);
        for (int it = gw; it < I_IN; it += NGW) transpose_item<1>(w_in, DM, INW, INW_PAD, Wt_in, scr, it, lane);
    }
    GRID_SYNC();
    const XcdBarrier xbar = xcd_barrier_post((unsigned*)(ws + WS_BAR), bar_st);

    for (int row = gw; row < SEQ; row += NGW) {
        const f32x4* xr = (const f32x4*)(x + (size_t)row * DM) + lane;
        f32x4 v[8]; float s = 0.f;
#pragma unroll
        for (int j = 0; j < 8; ++j) { v[j] = xr[64 * j]; s += (v[j][0] + v[j][1]) + (v[j][2] + v[j][3]); }
        const float mean = wave_sum(s) * (1.f / DM); float s2 = 0.f;
#pragma unroll
        for (int j = 0; j < 8; ++j) { v[j] = v[j] - mean; s2 += (v[j][0] * v[j][0] + v[j][1] * v[j][1]) + (v[j][2] * v[j][2] + v[j][3] * v[j][3]); }
        const float rstd = 1.f / sqrtf(wave_sum(s2) * (1.f / DM) + LN_EPS);
        u32x2* o8 = (u32x2*)(hbuf + (size_t)row * DM) + lane;
#pragma unroll
        for (int j = 0; j < 8; ++j) { const f32x4 sh = *((const f32x4*)modv + lane + 64 * j), sc = *((const f32x4*)(modv + DM) + lane + 64 * j);
            const f32x4 y = v[j] * rstd * (sc + 1.f) + sh; u32x2 w; w.x = pk2(y[0], y[1]); w.y = pk2(y[2], y[3]); o8[64 * j] = w; }
    }
    xcd_barrier(xbar);

    {
        pg8::Gemm g{hbuf, Wt_in, SEQ, INW_PAD, DM}; pg8::StaticOrder S; S.init(SEQ, INW_PAD, G, bx);
        pg8::EpiIn E{lat, sgate, pool_in, spgate, gates, b_gates};
        pg8::gemm_phase<pg8::EpiIn, pg8::StaticOrder, true, true>(ldsl, g, S, E);
    }
    if (bx >= 64 || G != 256) {
        LAS float* scr = (LAS float*)(ldsl + wave * 16384);
        constexpr int I_QB = (QLR / 64) * (3072 / 32), I_KVB = (KVLR / 64) * (4096 / 32), I_MLAO = (MLAW / 64) * (DM / 32),
                      I_PG = (256 / 64) * (256 / 32), I_PO = (POOLW / 64) * (DM / 32), I_OUT = (DM / 64) * (DM / 32);
        constexpr int NITEMS = I_QB + I_KVB + I_MLAO + 4 * I_PG + I_PO + I_OUT;
        const int w0 = (G == 256 ? (bx - 64) : bx) * NWAVES + wave, nw = (G == 256 ? (G - 64) : G) * NWAVES;
        for (int it = w0; it < NITEMS; it += nw) {
            int r = it;
            if (r < I_QB) { transpose_item<2>(w_q_b, QLR, 3072, 3072, Wt_qb, scr, r, lane); continue; } r -= I_QB;
            if (r < I_KVB) { transpose_item<3>(w_kv_b, KVLR, 4096, 4096, Wt_kvb, scr, r, lane); continue; } r -= I_KVB;
            if (r < I_MLAO) { transpose_item<0>(w_mla_o, MLAW, DM, DM, Wt_mlao, scr, r, lane); continue; } r -= I_MLAO;
            if (r < 4 * I_PG) { const int g = r / I_PG; transpose_item<0>(w_pool_g + (size_t)g * 65536, 256, 256, 256, Wt_poolg + (size_t)g * 65536, scr, r % I_PG, lane); continue; } r -= 4 * I_PG;
            if (r < I_PO) { transpose_item<0>(w_pool_o, POOLW, DM, DM, Wt_poolo, scr, r, lane); continue; } r -= I_PO;
            transpose_item<0>(w_out, DM, DM, DM, Wt_out, scr, r, lane);
        }
    }
    xcd_barrier(xbar);

    for (int row = gw; row < SEQ; row += NGW) {
        const float* lr = lat + (size_t)row * LATW;
#pragma unroll
        for (int part = 0; part < 2; ++part) {
            const f32x4* p = (const f32x4*)(lr + part * 512) + lane; const f32x4 a0 = p[0], a1 = p[64];
            const float ss = wave_sum((a0[0] * a0[0] + a0[1] * a0[1]) + (a0[2] * a0[2] + a0[3] * a0[3]) + (a1[0] * a1[0] + a1[1] * a1[1]) + (a1[2] * a1[2] + a1[3] * a1[3]));
            const float r = 1.f / sqrtf(ss * (1.f / 512.f) + RMS_EPS);
            const f32x4* gp = (const f32x4*)(part ? kv_norm_g : q_norm_g) + lane; const f32x4 g0 = gp[0], g1 = gp[64];
            u32x2* o = (u32x2*)((part ? kvn : qn) + (size_t)row * 512) + lane;
            const f32x4 y0 = a0 * r * g0, y1 = a1 * r * g1; u32x2 w0, w1; w0.x = pk2(y0[0], y0[1]); w0.y = pk2(y0[2], y0[3]); w1.x = pk2(y1[0], y1[1]); w1.y = pk2(y1[2], y1[3]);
            o[0] = w0; o[64] = w1;
        }
        if (lane < 32) { const int blk = lane >> 2, w = lane & 3; const float x1 = lr[1024 + 8 * blk + w], x2 = lr[1024 + 8 * blk + 4 + w];
            const float cn = cs[(size_t)row * 64 + 2 * lane], sn = cs[(size_t)row * 64 + 2 * lane + 1];
            bf16_t* kp = Kp + (size_t)row * DROPE + 8 * blk + w;
            kp[0] = (bf16_t)(pk2(x1 * cn - x2 * sn, 0.f) & 0xffffu); kp[4] = (bf16_t)(pk2(x1 * sn + x2 * cn, 0.f) & 0xffffu); }
#pragma unroll
        for (int g = 0; g < 4; ++g) {
            const int wlen = 2 << g, cnt = (row + 1 < wlen) ? row + 1 : wlen;
            const f32x4* up = (const f32x4*)(pool_in + (size_t)row * POOLW + 256 * g) + lane; const f32x4 u0 = *up; f32x4 sum = u0;
            for (int j = 1; j < cnt; ++j) sum += *(up - (size_t)j * (POOLW / 4));
            const f32x4 pv = sum * (1.f / (float)cnt) - u0; u32x2 w; w.x = pk2(pv[0], pv[1]); w.y = pk2(pv[2], pv[3]);
            *((u32x2*)(pooled + ((size_t)g * SEQ + row) * 256) + lane) = w;
        }
    }
    xcd_barrier(xbar);

    {
        pg8::Gemm g{qn, Wt_qb, SEQ, 3072, QLR}; pg8::StaticOrder S; S.init(SEQ, 3072, G, bx);
        pg8::EpiQ E{Qb, cs};
        pg8::gemm_phase<pg8::EpiQ, pg8::StaticOrder, true, true>(ldsl, g, S, E);
    }
    {
        pg8::Gemm g{kvn, Wt_kvb, SEQ, 4096, KVLR}; pg8::StaticOrder S; S.init(SEQ, 4096, G, bx);
        pg8::EpiKV E{Kn, Vb};
        pg8::gemm_phase<pg8::EpiKV, pg8::StaticOrder, true, true>(ldsl, g, S, E);
    }
    {
        int kpool = 256; asm volatile("" : "+s"(kpool));
        pg8::Gemm g{pooled, Wt_poolg, 4 * SEQ, 256, kpool}; pg8::PoolOrder S{G, bx};
        pg8::EpiPool E{pmix, spgate, pool_scale};
        pg8::gemm_phase<pg8::EpiPool, pg8::PoolOrder, false, true>(ldsl, g, S, E);
    }
    xcd_barrier(xbar);

    {
        const att::Tensors T{Qb, Kn, Kp, Vb, sgate};
        att::attn_phase((char*)lds, T, vcu, G);
    }
    xcd_barrier(xbar);

    {
    {
        pg8::Gemm g{sgate, Wt_mlao, SEQ, DM, MLAW}; pg8::StaticOrder S; S.init(SEQ, DM, G, bx);
        pg8::EpiMlaO E{zb, gates};
        pg8::gemm_phase<pg8::EpiMlaO, pg8::StaticOrder, false, true>(ldsl, g, S, E);
    }
    {
        pg8::Gemm g{pmix, Wt_poolo, SEQ, DM, POOLW}; pg8::StaticOrder S; S.init(SEQ, DM, G, bx);
        pg8::EpiPoolO E{zb, gates};
        pg8::gemm_phase<pg8::EpiPoolO, pg8::StaticOrder, false, true>(ldsl, g, S, E);
    }
    }
    xcd_barrier(xbar);

    {
        pg8::Gemm g{zb, Wt_out, SEQ, DM, DM}; pg8::StaticOrder S; S.init(SEQ, DM, G, bx);
        pg8::EpiOut E{a.out, x, modv};
        pg8::gemm_phase<pg8::EpiOut, pg8::StaticOrder, false, true>(ldsl, g, S, E);
    }
    xcd_barrier(xbar);

    for (int row = gw; row < SEQ; row += NGW) {
        f32x4* xr = (f32x4*)(a.out + (size_t)row * DM) + lane;
        f32x4 v[8]; float s = 0.f;
#pragma unroll
        for (int j = 0; j < 8; ++j) { v[j] = xr[64 * j]; s += (v[j][0] + v[j][1]) + (v[j][2] + v[j][3]); }
        const float mean = wave_sum(s) * (1.f / DM); float s2 = 0.f;
#pragma unroll
        for (int j = 0; j < 8; ++j) { v[j] = v[j] - mean; s2 += (v[j][0] * v[j][0] + v[j][1] * v[j][1]) + (v[j][2] * v[j][2] + v[j][3] * v[j][3]); }
        const float rstd = 1.f / sqrtf(wave_sum(s2) * (1.f / DM) + LN_EPS);
#pragma unroll
        for (int j = 0; j < 8; ++j) { const f32x4 gg = *((const f32x4*)ln_g + lane + 64 * j), bb = *((const f32x4*)ln_b + lane + 64 * j);
            xr[64 * j] = v[j] * rstd * gg + bb; }

    }
}

extern "C" void kernel_launch(void* const* d_in, const int* in_sizes, int n_in, void* d_out, int out_size, void* d_ws, size_t ws_size, hipStream_t stream) {
    static int grid_blocks = 0;
    if (grid_blocks == 0) {
        if (n_in != 18 || out_size != SEQ * DM || ws_size < WS_END) { fprintf(stderr, "kernel_launch: unexpected shapes (n_in %d out %d ws %zu)\n", n_in, out_size, ws_size); grid_blocks = -1; return; }
        int dev = 0, cus = 0, per_cu = 0;
        (void)hipGetDevice(&dev); (void)hipDeviceGetAttribute(&cus, hipDeviceAttributeMultiprocessorCount, dev);
        if (hipFuncSetAttribute((const void*)mk_fwd, hipFuncAttributeMaxDynamicSharedMemorySize, LDS_BYTES) != hipSuccess) { fprintf(stderr, "kernel_launch: hipFuncSetAttribute failed\n"); grid_blocks = -1; return; }
        if (hipOccupancyMaxActiveBlocksPerMultiprocessor(&per_cu, (const void*)mk_fwd, NTHREADS, LDS_BYTES) != hipSuccess || per_cu < 1) per_cu = 1;
        (void)hipGetLastError();
        grid_blocks = cus * per_cu;
    }
    if (grid_blocks < 0) return;
    Args a{};
    for (int i = 0; i < 18; ++i) a.in[i] = d_in[i];
    a.out = (float*)d_out; a.ws = (unsigned char*)d_ws;
    void* args[] = {&a};
    hipError_t e = hipLaunchCooperativeKernel((const void*)mk_fwd, dim3(grid_blocks), dim3(NTHREADS), args, LDS_BYTES, stream);
    if (e != hipSuccess) fprintf(stderr, "cooperative launch failed: %s (grid %d)\n", hipGetErrorString(e), grid_blocks);
}
```

```cpp
#include <hip/hip_runtime.h>
#include <hip/hip_cooperative_groups.h>
#include <cstdio>
#include <cstdint>
namespace cg = cooperative_groups;
namespace pg8 {
#define PG8_LAS __attribute__((address_space(3)))
typedef unsigned short bf16_t;
typedef short bf16x8 __attribute__((ext_vector_type(8)));
typedef float f32x4 __attribute__((ext_vector_type(4)));
typedef unsigned u32x4 __attribute__((ext_vector_type(4)));
constexpr int BM = 256, BK = 64, HALF = 128, HTB = HALF * BK * 2  , STAGE_BYTES = 8 * HTB, NXCD = 8, WGM = 8;

__host__ __device__ __forceinline__ int lds_byte(int r, int c) { const int st = (r >> 4) * 2 + (c >> 5), rr = r & 15, cc = c & 31, ob = rr * 64 + cc * 2; return st * 1024 + (ob ^ (((ob >> 9) & 1) << 5)); }
__host__ __device__ __forceinline__ void stage_rc(int b, int& R, int& C) { const int st = b / 1024, sb = b % 1024, swz = sb ^ (((sb >> 9) & 1) << 5); R = (st >> 1) * 16 + swz / 64; C = (st & 1) * 32 + (swz % 64) / 2; }
__host__ __device__ __forceinline__ int perm32(int rho) { const int n = rho >> 4, i = rho & 15; return 8 * (i >> 2) + 4 * n + (i & 3); }

struct Unit { int pm, pn; };
struct Gemm { const bf16_t* A; const bf16_t* Bt; int M, N, K; };

struct StaticOrder {
    int nM, nN, nwg, G, c;
    __host__ __device__ void init(int M, int N, int G_, int c_) { nM = M / BM; nN = N / BM; nwg = nM * nN; G = G_; c = c_; }
    __host__ __device__ bool next(int i, Unit& u) const {
        const long L = (long)i * G + c; if (L >= nwg) return false;
        int wgid = (int)L; { const int q = nwg / NXCD, r = nwg % NXCD, xcd = wgid % NXCD, off = wgid / NXCD; wgid = (xcd < r ? xcd * (q + 1) : r * (q + 1) + (xcd - r) * q) + off; }
        const int nig = WGM * nN, gid = wgid / nig, fm = gid * WGM, gsz = (nM - fm) < WGM ? (nM - fm) : WGM;
        u.pm = fm + ((wgid % nig) % gsz); u.pn = (wgid % nig) / gsz; return true;
    }
    __device__ __forceinline__ void a_ready(const Unit&) const {}
    __device__ __forceinline__ void done(const Unit&) const {}
};

typedef float f32x2c __attribute__((ext_vector_type(2)));
typedef __bf16 bf16x2c __attribute__((ext_vector_type(2)));
__device__ __forceinline__ unsigned cvt_pk_bf16(float lo, float hi) { const f32x2c v = {lo, hi}; return __builtin_bit_cast(unsigned, __builtin_convertvector(v, bf16x2c)); }
template <class Epi, class Sched, bool ALIGN_EPI = false, bool SP2 = false>
__device__ __forceinline__ void gemm_phase(PG8_LAS unsigned char* lds, const Gemm g, const Sched& S, const Epi& E) {
    int tid_ = threadIdx.x; asm volatile("" : "+v"(tid_));
    const int tid = tid_, wid = __builtin_amdgcn_readfirstlane(tid >> 6), lane = tid & 63, wr = wid >> 2, wc = wid & 3, fr = lane & 15, fq = lane >> 4;
    const int K = g.K, nt = K / BK;
    unsigned voffA[2], voffB[2];
#pragma unroll
    for (int i = 0; i < 2; ++i) { int R, C; stage_rc(tid * 16 + i * 8192, R, C); const int Rb = Epi::PERM ? ((R & ~31) + perm32(R & 31)) : R;
        voffA[i] = (unsigned)(R * K + C) * 2u; voffB[i] = (unsigned)(Rb * K + C) * 2u; }
    const size_t kstep = (size_t)(BK * 2);
    const size_t hstep = (size_t)HALF * K * 2;
    const size_t tstep = 2 * hstep;
    const unsigned ldsw = (unsigned)wid * 1024u;
    const int aoff = lds_byte(wr * 64 + fr, fq * 8), boff = lds_byte(wc * 32 + fr, fq * 8);
#define PG8_SA(b, h) (((b) * 2 + (h)) * HTB)
#define PG8_SB(b, h) ((4 + (b) * 2 + (h)) * HTB)
#define PG8_STAGE(bufoff, gbase, voff) do { _Pragma("unroll") for (int _i = 0; _i < 2; ++_i) \
        __builtin_amdgcn_global_load_lds((const unsigned*)((const char*)(gbase) + (voff)[_i]), (PG8_LAS unsigned*)(lds + (bufoff) + ldsw + _i * 8192), 16, 0, 0); } while (0)
#define PG8_LDA(dst, b, h) do { _Pragma("unroll") for (int m = 0; m < 4; ++m) _Pragma("unroll") for (int k = 0; k < 2; ++k) dst[m][k] = *(const PG8_LAS bf16x8*)(lds + PG8_SA(b, h) + aoff + m * 2048 + k * 1024); } while (0)
#define PG8_LDB(dst, b, h) do { _Pragma("unroll") for (int n = 0; n < 2; ++n) _Pragma("unroll") for (int k = 0; k < 2; ++k) dst[n][k] = *(const PG8_LAS bf16x8*)(lds + PG8_SB(b, h) + boff + n * 2048 + k * 1024); } while (0)
#define PG8_MMA(ai, bj, At, Bt) do { __builtin_amdgcn_s_setprio(1); _Pragma("unroll") for (int m = 0; m < 4; ++m) _Pragma("unroll") for (int n = 0; n < 2; ++n) _Pragma("unroll") for (int k = 0; k < 2; ++k) \
        acc[ai][bj][m][n] = __builtin_amdgcn_mfma_f32_16x16x32_bf16(Bt[n][k], At[m][k], acc[ai][bj][m][n], 0, 0, 0); __builtin_amdgcn_s_setprio(0); } while (0)
#define PG8_WAIT_V(n) asm volatile("s_waitcnt vmcnt(" #n ")" ::: "memory")
#define PG8_WAIT_L(n) asm volatile("s_waitcnt lgkmcnt(" #n ")" ::: "memory")
#define PG8_BAR __builtin_amdgcn_s_barrier()
#define PG8_SCHED __builtin_amdgcn_sched_barrier(0)
    Unit cur, nxt; int ui = 0;
    if (!S.next(0, cur)) return;
    f32x4 acc[2][2][4][2];
#pragma unroll
    for (int a = 0; a < 2; ++a)
#pragma unroll
        for (int b = 0; b < 2; ++b)
#pragma unroll
            for (int m = 0; m < 4; ++m)
#pragma unroll
                for (int n = 0; n < 2; ++n) acc[a][b][m][n] = (f32x4){0.f, 0.f, 0.f, 0.f};
    bf16x8 At[4][2], B0[2][2], B1[2][2];
    const char* cA = (const char*)g.A + (size_t)cur.pm * tstep; const char* cB = (const char*)g.Bt + (size_t)cur.pn * tstep;
    S.a_ready(cur);
    if constexpr (SP2) {
        PG8_STAGE(PG8_SB(0, 0), cB, voffB); PG8_STAGE(PG8_SB(0, 1), cB + hstep, voffB); PG8_STAGE(PG8_SA(0, 0), cA, voffA); PG8_STAGE(PG8_SA(0, 1), cA + hstep, voffA);
        if (wr == 1) PG8_BAR;
        PG8_WAIT_V(2); PG8_BAR;
        PG8_STAGE(PG8_SB(1, 0), cB + kstep, voffB); PG8_STAGE(PG8_SA(1, 0), cA + kstep, voffA); PG8_STAGE(PG8_SB(1, 1), cB + hstep + kstep, voffB);
        PG8_WAIT_V(6); PG8_BAR;
    } else {
        PG8_STAGE(PG8_SB(0, 0), cB, voffB); PG8_STAGE(PG8_SA(0, 0), cA, voffA); PG8_STAGE(PG8_SB(0, 1), cB + hstep, voffB); PG8_STAGE(PG8_SA(0, 1), cA + hstep, voffA);
        if (wr == 1) PG8_BAR;
        PG8_WAIT_V(4); PG8_BAR;
        PG8_STAGE(PG8_SB(1, 0), cB + kstep, voffB); PG8_STAGE(PG8_SA(1, 0), cA + kstep, voffA); PG8_STAGE(PG8_SB(1, 1), cB + hstep + kstep, voffB);
        PG8_WAIT_V(6); PG8_BAR;
    }
    for (;;) {
        const bool has_next = S.next(ui + 1, nxt);
        const char* nA = has_next ? (const char*)g.A + (size_t)nxt.pm * tstep : cA; const char* nB = has_next ? (const char*)g.Bt + (size_t)nxt.pn * tstep : cB;
        for (int t = 0; t < nt; t += 2) {
            const bool last = (t == nt - 2);
            const char* a1 = cA + (size_t)(t + 1) * kstep;
            const char* a2 = last ? nA : cA + (size_t)(t + 2) * kstep; const char* b2 = last ? nB : cB + (size_t)(t + 2) * kstep;
            const char* a3 = a2 + kstep; const char* b3 = b2 + kstep;
            if (last && has_next) S.a_ready(nxt);
            if constexpr (SP2) {
            PG8_LDB(B0, 0, 0); PG8_LDB(B1, 0, 1); PG8_SCHED; PG8_LDA(At, 0, 0); PG8_STAGE(PG8_SA(1, 1), a1 + hstep, voffA);
            PG8_WAIT_V(8); PG8_WAIT_L(0); PG8_BAR; PG8_MMA(0, 0, At, B0); PG8_MMA(0, 1, At, B1); PG8_BAR; PG8_SCHED;
            PG8_LDA(At, 0, 1); PG8_STAGE(PG8_SB(0, 0), b2, voffB); PG8_STAGE(PG8_SB(0, 1), b2 + hstep, voffB); PG8_STAGE(PG8_SA(0, 0), a2, voffA);
            PG8_WAIT_V(8); PG8_WAIT_L(0); PG8_BAR; PG8_MMA(1, 0, At, B0); PG8_MMA(1, 1, At, B1); PG8_BAR; PG8_SCHED;
            PG8_LDB(B0, 1, 0); PG8_LDB(B1, 1, 1); PG8_SCHED; PG8_LDA(At, 1, 0); PG8_STAGE(PG8_SA(0, 1), a2 + hstep, voffA);
            PG8_WAIT_V(8); PG8_WAIT_L(0); PG8_BAR; PG8_MMA(0, 0, At, B0); PG8_MMA(0, 1, At, B1); PG8_BAR; PG8_SCHED;
            PG8_LDA(At, 1, 1); PG8_STAGE(PG8_SB(1, 0), b3, voffB); PG8_STAGE(PG8_SB(1, 1), b3 + hstep, voffB); PG8_STAGE(PG8_SA(1, 0), a3, voffA);
            PG8_WAIT_V(8); PG8_WAIT_L(0); PG8_BAR; PG8_MMA(1, 0, At, B0); PG8_MMA(1, 1, At, B1); PG8_BAR; PG8_SCHED;
            } else {
            PG8_LDB(B0, 0, 0); PG8_SCHED; PG8_LDA(At, 0, 0); PG8_STAGE(PG8_SA(1, 1), a1 + hstep, voffA);
            PG8_WAIT_L(8); PG8_BAR; PG8_WAIT_L(0); PG8_MMA(0, 0, At, B0); PG8_BAR; PG8_SCHED;
            PG8_LDB(B1, 0, 1); PG8_STAGE(PG8_SB(0, 0), b2, voffB);
            PG8_BAR; PG8_WAIT_L(0); PG8_MMA(0, 1, At, B1); PG8_BAR;
            PG8_LDA(At, 0, 1); PG8_STAGE(PG8_SA(0, 0), a2, voffA);
            PG8_BAR; PG8_WAIT_L(0); PG8_MMA(1, 0, At, B0); PG8_BAR; PG8_SCHED;
            PG8_STAGE(PG8_SB(0, 1), b2 + hstep, voffB);
            PG8_WAIT_V(6); PG8_BAR; PG8_MMA(1, 1, At, B1); PG8_BAR;
            PG8_LDB(B0, 1, 0); PG8_SCHED; PG8_LDA(At, 1, 0); PG8_STAGE(PG8_SA(0, 1), a2 + hstep, voffA);
            PG8_WAIT_L(8); PG8_BAR; PG8_WAIT_L(0); PG8_MMA(0, 0, At, B0); PG8_BAR; PG8_SCHED;
            PG8_LDB(B1, 1, 1); PG8_STAGE(PG8_SB(1, 0), b3, voffB);
            PG8_BAR; PG8_WAIT_L(0); PG8_MMA(0, 1, At, B1); PG8_BAR;
            PG8_LDA(At, 1, 1); PG8_STAGE(PG8_SA(1, 0), a3, voffA);
            PG8_BAR; PG8_WAIT_L(0); PG8_MMA(1, 0, At, B0); PG8_BAR; PG8_SCHED;
            PG8_STAGE(PG8_SB(1, 1), b3 + hstep, voffB);
            PG8_WAIT_V(6); PG8_BAR; PG8_MMA(1, 1, At, B1); PG8_BAR;
            }
        }
        if constexpr (ALIGN_EPI) { if (wr == 0) PG8_BAR; }
        if constexpr (!Epi::AFTER_DRAIN) { E(acc, cur, wr, wc, fr, fq); S.done(cur); }
        if (!has_next) break;
#pragma unroll
        for (int a = 0; a < 2; ++a)
#pragma unroll
            for (int b = 0; b < 2; ++b)
#pragma unroll
                for (int m = 0; m < 4; ++m)
#pragma unroll
                    for (int n = 0; n < 2; ++n) acc[a][b][m][n] = (f32x4){0.f, 0.f, 0.f, 0.f};
        cur = nxt; cA = nA; cB = nB; ++ui;
        if constexpr (ALIGN_EPI) { if (wr == 1) PG8_BAR; }
    }
    PG8_WAIT_V(0);
    if constexpr (!ALIGN_EPI) { if (wr == 0) PG8_BAR; }
    PG8_BAR;
    if constexpr (Epi::AFTER_DRAIN) { E.fused(acc, cur, wr, wc, fr, fq, lds, wid, lane); S.done(cur); }
#undef PG8_SA
#undef PG8_SB
#undef PG8_STAGE
#undef PG8_LDA
#undef PG8_LDB
#undef PG8_MMA
#undef PG8_WAIT_V
#undef PG8_WAIT_L
#undef PG8_BAR
#undef PG8_SCHED
}
}

constexpr int SEQ = 16384, DM = 2048, NH = 16, DQK = 192, DNOPE = 128, DROPE = 64, DV = 128;
constexpr int QLR = 512, KVLR = 512, MLAW = 2048, POOLW = 1024, INW = 9280, INW_PAD = 9472, LATW = 1088;
constexpr float RMS_EPS = 1e-6f, LN_EPS = 1e-5f;
constexpr float DN_ALPHA = 1.189207115002721f;

namespace pg8 {
typedef unsigned u32x2 __attribute__((ext_vector_type(2)));
__device__ __forceinline__ u32x4 pack8(f32x4 a, f32x4 b) { u32x4 w; w.x = cvt_pk_bf16(a[0], a[1]); w.y = cvt_pk_bf16(a[2], a[3]); w.z = cvt_pk_bf16(b[0], b[1]); w.w = cvt_pk_bf16(b[2], b[3]); return w; }
__device__ __forceinline__ float bf_lo(unsigned w) { return __uint_as_float(w << 16); }
__device__ __forceinline__ float bf_hi(unsigned w) { return __uint_as_float(w & 0xffff0000u); }
__device__ __forceinline__ void unpack8(u32x4 w, f32x4& a, f32x4& b) { a = (f32x4){bf_lo(w.x), bf_hi(w.x), bf_lo(w.y), bf_hi(w.y)}; b = (f32x4){bf_lo(w.z), bf_hi(w.z), bf_lo(w.w), bf_hi(w.w)}; }
__device__ __forceinline__ float sigmoid_f(float v) { return __builtin_amdgcn_rcpf(1.f + __expf(-v)); }
__device__ __forceinline__ f32x4 sigmoid4(f32x4 v) { return (f32x4){sigmoid_f(v[0]), sigmoid_f(v[1]), sigmoid_f(v[2]), sigmoid_f(v[3])}; }
__device__ __forceinline__ f32x4 silu4(f32x4 v) { return v * sigmoid4(v); }

#define EPI_FOR(ai, m, bj) _Pragma("unroll") for (int ai = 0; ai < 2; ++ai) _Pragma("unroll") for (int m = 0; m < 4; ++m) _Pragma("unroll") for (int bj = 0; bj < 2; ++bj)
#define EPI_ROWB(ai, m, LD, ES) ((size_t)((ai) * HALF + (m) * 16) * (LD) * (ES))
#define EPI_FENCE(bj) do { if ((bj) == 1) asm volatile("" ::: "memory"); } while (0)

struct EpiIn {
    static constexpr bool PERM = true, AFTER_DRAIN = false;
    float* lat; bf16_t* sgate; float* pool_in; bf16_t* spgate; bf16_t* gates; const float* b_gates;
    __device__ __forceinline__ void operator()(const f32x4 (&acc)[2][2][4][2], const Unit& u, int wr, int wc, int fr, int fq) const {
        const int pn = u.pn, rowu = u.pm * BM + wr * 64, colu = wc * 32;
        if (pn < 5) {
            const unsigned lo = (unsigned)(fr * LATW + 8 * fq) * 4u; char* ub = (char*)lat + ((size_t)rowu * LATW + pn * BM + colu) * 4;
            EPI_FOR(ai, m, bj) { if (pn < 4 || (bj == 0 && wc < 2)) { char* p = ub + EPI_ROWB(ai, m, LATW, 4) + bj * (HALF * 4) + lo;
                __builtin_nontemporal_store(acc[ai][bj][m][0], (f32x4*)p); __builtin_nontemporal_store(acc[ai][bj][m][1], (f32x4*)(p + 16)); } }
        } else if (pn < 13) {
            const unsigned lo = (unsigned)(fr * MLAW + 8 * fq) * 2u; char* ub = (char*)sgate + ((size_t)rowu * MLAW + (pn - 5) * BM + colu) * 2;
            EPI_FOR(ai, m, bj) { __builtin_nontemporal_store(pack8(silu4(acc[ai][bj][m][0]), silu4(acc[ai][bj][m][1])), (u32x4*)(ub + EPI_ROWB(ai, m, MLAW, 2) + bj * (HALF * 2) + lo)); }
        } else if (pn < 17) {
            const unsigned lo = (unsigned)(fr * POOLW + 8 * fq) * 4u; char* ub = (char*)pool_in + ((size_t)rowu * POOLW + (pn - 13) * BM + colu) * 4;
            EPI_FOR(ai, m, bj) { char* p = ub + EPI_ROWB(ai, m, POOLW, 4) + bj * (HALF * 4) + lo; __builtin_nontemporal_store(acc[ai][bj][m][0], (f32x4*)p); __builtin_nontemporal_store(acc[ai][bj][m][1], (f32x4*)(p + 16)); }
        } else if (pn < 21) {
            const unsigned lo = (unsigned)(fr * POOLW + 8 * fq) * 2u; char* ub = (char*)spgate + ((size_t)rowu * POOLW + (pn - 17) * BM + colu) * 2;
            EPI_FOR(ai, m, bj) { __builtin_nontemporal_store(pack8(silu4(acc[ai][bj][m][0]), silu4(acc[ai][bj][m][1])), (u32x4*)(ub + EPI_ROWB(ai, m, POOLW, 2) + bj * (HALF * 2) + lo)); }
        } else {
            f32x4 bv[2][2];
#pragma unroll
            for (int bj = 0; bj < 2; ++bj) { const float* bp = b_gates + (pn - 21) * BM + bj * HALF + colu + 8 * fq; bv[bj][0] = *(const f32x4*)bp; bv[bj][1] = *(const f32x4*)(bp + 4); }
            const unsigned lo = (unsigned)(fr * (2 * DM) + 8 * fq) * 2u; char* ub = (char*)gates + ((size_t)rowu * (2 * DM) + (pn - 21) * BM + colu) * 2;
            EPI_FOR(ai, m, bj) { __builtin_nontemporal_store(pack8(sigmoid4(acc[ai][bj][m][0] + bv[bj][0]), sigmoid4(acc[ai][bj][m][1] + bv[bj][1])), (u32x4*)(ub + EPI_ROWB(ai, m, 2 * DM, 2) + bj * (HALF * 2) + lo)); }
        }
    }
};
struct EpiQ {
    static constexpr bool PERM = true, AFTER_DRAIN = false;
    bf16_t* Q; const float* cs;
    __device__ __forceinline__ void operator()(const f32x4 (&acc)[2][2][4][2], const Unit& u, int wr, int wc, int fr, int fq) const {
        const int pn = u.pn, rowu = u.pm * BM + wr * 64;
        const unsigned lo = (unsigned)(fr * DQK + 8 * fq) * 2u;
        if (pn < 8) {
            char* ub = (char*)Q + (((size_t)(pn * 2) * SEQ + rowu) * DQK + wc * 32) * 2;
            EPI_FOR(ai, m, bj) { *(u32x4*)(ub + EPI_ROWB(ai, m, DQK, 2) + (size_t)bj * ((size_t)SEQ * DQK * 2) + lo) = pack8(acc[ai][bj][m][0], acc[ai][bj][m][1]); }
        } else {
            const int h0 = (pn - 8) * 4 + (wc >> 1), ju = (wc & 1) * 32;
            char* ub = (char*)Q + (((size_t)h0 * SEQ + rowu) * DQK + DNOPE + ju) * 2;
            const unsigned lc = (unsigned)(fr * 64 + 8 * fq) * 4u; const char* cb = (const char*)cs + ((size_t)rowu * 64 + ju) * 4;
            _Pragma("unroll") for (int ai = 0; ai < 2; ++ai) { f32x4 tv[4][2];
                _Pragma("unroll") for (int m = 0; m < 4; ++m) { const char* cp = cb + EPI_ROWB(ai, m, 64, 4) + lc; tv[m][0] = *(const f32x4*)cp; tv[m][1] = *(const f32x4*)(cp + 16); }
                asm volatile("" ::: "memory");
                _Pragma("unroll") for (int m = 0; m < 4; ++m) _Pragma("unroll") for (int bj = 0; bj < 2; ++bj) { const f32x4 t0 = tv[m][0], t1 = tv[m][1];
                    const f32x4 c = (f32x4){t0[0], t0[2], t1[0], t1[2]}, s = (f32x4){t0[1], t0[3], t1[1], t1[3]};
                    const f32x4 x1 = acc[ai][bj][m][0], x2 = acc[ai][bj][m][1];
                    *(u32x4*)(ub + EPI_ROWB(ai, m, DQK, 2) + (size_t)bj * ((size_t)2 * SEQ * DQK * 2) + lo) = pack8(x1 * c - x2 * s, x1 * s + x2 * c); }
                asm volatile("" ::: "memory"); }
        }
    }
};
struct EpiKV {
    static constexpr bool PERM = true, AFTER_DRAIN = false;
    bf16_t* Kn; bf16_t* V;
    __device__ __forceinline__ void operator()(const f32x4 (&acc)[2][2][4][2], const Unit& u, int wr, int wc, int fr, int fq) const {
        const int pn = u.pn, rowu = u.pm * BM + wr * 64;
        const unsigned lo = (unsigned)(fr * 128 + 8 * fq) * 2u;
        char* ub = (char*)(pn < 8 ? Kn : V) + (((size_t)((pn & 7) * 2) * SEQ + rowu) * 128 + wc * 32) * 2;
        EPI_FOR(ai, m, bj) { *(u32x4*)(ub + EPI_ROWB(ai, m, 128, 2) + (size_t)bj * ((size_t)SEQ * 128 * 2) + lo) = pack8(acc[ai][bj][m][0], acc[ai][bj][m][1]); }
    }
};
#define EPI_HALF(ai) _Pragma("unroll") for (int ai = 0; ai < 2; ++ai)
#define EPI_MB(m, bj) _Pragma("unroll") for (int m = 0; m < 4; ++m) _Pragma("unroll") for (int bj = 0; bj < 2; ++bj)
#define EPI_MEMFENCE() asm volatile("" ::: "memory")
struct EpiPool {
    static constexpr bool PERM = true, AFTER_DRAIN = false;
    bf16_t* pmix; const bf16_t* spgate; const float* pool_scale;
    __device__ __forceinline__ void operator()(const f32x4 (&acc)[2][2][4][2], const Unit& u, int wr, int wc, int fr, int fq) const {
        const int g = u.pn, rowu = (u.pm & 63) * BM + wr * 64, colu = g * 256 + wc * 32;
        f32x4 sv[2][2];
#pragma unroll
        for (int bj = 0; bj < 2; ++bj) { const float* sp = pool_scale + colu + bj * HALF + 8 * fq; sv[bj][0] = *(const f32x4*)sp; sv[bj][1] = *(const f32x4*)(sp + 4); }
        const unsigned lo = (unsigned)(fr * POOLW + 8 * fq) * 2u; const size_t uo = ((size_t)rowu * POOLW + colu) * 2;
        EPI_HALF(ai) { u32x4 gw[4][2];
            EPI_MB(m, bj) gw[m][bj] = *(const u32x4*)((const char*)spgate + uo + EPI_ROWB(ai, m, POOLW, 2) + bj * (HALF * 2) + lo);
            EPI_MEMFENCE();
            EPI_MB(m, bj) { f32x4 g0, g1; unpack8(gw[m][bj], g0, g1);
                *(u32x4*)((char*)pmix + uo + EPI_ROWB(ai, m, POOLW, 2) + bj * (HALF * 2) + lo) = pack8(acc[ai][bj][m][0] * sv[bj][0] * g0, acc[ai][bj][m][1] * sv[bj][1] * g1); }
            EPI_MEMFENCE(); }
    }
};
struct EpiMlaO {
    static constexpr bool PERM = true, AFTER_DRAIN = false;
    bf16_t* z; const bf16_t* gates;
    __device__ __forceinline__ void operator()(const f32x4 (&acc)[2][2][4][2], const Unit& u, int wr, int wc, int fr, int fq) const {
        const int rowu = u.pm * BM + wr * 64, colu = u.pn * BM + wc * 32;
        const unsigned loz = (unsigned)(fr * DM + 8 * fq) * 2u, log_ = (unsigned)(fr * (2 * DM) + 8 * fq) * 2u;
        char* zb_ = (char*)z + ((size_t)rowu * DM + colu) * 2; const char* gb_ = (const char*)gates + ((size_t)rowu * (2 * DM) + colu) * 2;
        EPI_HALF(ai) { u32x4 gw[4][2];
            EPI_MB(m, bj) gw[m][bj] = *(const u32x4*)(gb_ + EPI_ROWB(ai, m, 2 * DM, 2) + bj * (HALF * 2) + log_);
            EPI_MEMFENCE();
            EPI_MB(m, bj) { f32x4 g0, g1; unpack8(gw[m][bj], g0, g1);
                *(u32x4*)(zb_ + EPI_ROWB(ai, m, DM, 2) + bj * (HALF * 2) + loz) = pack8(acc[ai][bj][m][0] * g0, acc[ai][bj][m][1] * g1); }
            EPI_MEMFENCE(); }
    }
};
struct EpiPoolO {
    static constexpr bool PERM = true, AFTER_DRAIN = false;
    bf16_t* z; const bf16_t* gates;
    __device__ __forceinline__ void operator()(const f32x4 (&acc)[2][2][4][2], const Unit& u, int wr, int wc, int fr, int fq) const {
        const int rowu = u.pm * BM + wr * 64, colu = u.pn * BM + wc * 32;
        const unsigned loz = (unsigned)(fr * DM + 8 * fq) * 2u, log_ = (unsigned)(fr * (2 * DM) + 8 * fq) * 2u;
        char* zb_ = (char*)z + ((size_t)rowu * DM + colu) * 2; const char* gb_ = (const char*)gates + ((size_t)rowu * (2 * DM) + DM + colu) * 2;
        EPI_HALF(ai) { u32x4 gw[4][2], zw[4][2];
            EPI_MB(m, bj) { gw[m][bj] = *(const u32x4*)(gb_ + EPI_ROWB(ai, m, 2 * DM, 2) + bj * (HALF * 2) + log_); zw[m][bj] = *(const u32x4*)(zb_ + EPI_ROWB(ai, m, DM, 2) + bj * (HALF * 2) + loz); }
            EPI_MEMFENCE();
            EPI_MB(m, bj) { f32x4 g0, g1, z0, z1; unpack8(gw[m][bj], g0, g1); unpack8(zw[m][bj], z0, z1);
                *(u32x4*)(zb_ + EPI_ROWB(ai, m, DM, 2) + bj * (HALF * 2) + loz) = pack8(z0 + acc[ai][bj][m][0] * g0, z1 + acc[ai][bj][m][1] * g1); }
            EPI_MEMFENCE(); }
    }
};
struct EpiOut {
    static constexpr bool PERM = true, AFTER_DRAIN = false;
    float* out; const float* x; const float* mod;
    __device__ __forceinline__ void operator()(const f32x4 (&acc)[2][2][4][2], const Unit& u, int wr, int wc, int fr, int fq) const {
        const int rowu = u.pm * BM + wr * 64, colu = u.pn * BM + wc * 32;
        f32x4 gv[2][2];
#pragma unroll
        for (int bj = 0; bj < 2; ++bj) { const float* gp = mod + 2 * DM + bj * HALF + colu + 8 * fq; gv[bj][0] = *(const f32x4*)gp + 1.f; gv[bj][1] = *(const f32x4*)(gp + 4) + 1.f; }
        const unsigned lo = (unsigned)(fr * DM + 8 * fq) * 4u; const size_t uo = ((size_t)rowu * DM + colu) * 4;
        EPI_HALF(ai) { f32x4 xv[4][2][2];
            EPI_MB(m, bj) { const char* xp = (const char*)x + uo + EPI_ROWB(ai, m, DM, 4) + bj * (HALF * 4) + lo; xv[m][bj][0] = *(const f32x4*)xp; xv[m][bj][1] = *(const f32x4*)(xp + 16); }
            EPI_MEMFENCE();
            EPI_MB(m, bj) { char* op = (char*)out + uo + EPI_ROWB(ai, m, DM, 4) + bj * (HALF * 4) + lo;
                *(f32x4*)op = xv[m][bj][0] * DN_ALPHA + gv[bj][0] * acc[ai][bj][m][0]; *(f32x4*)(op + 16) = xv[m][bj][1] * DN_ALPHA + gv[bj][1] * acc[ai][bj][m][1]; }
            EPI_MEMFENCE(); }
    }
};
struct PoolOrder {
    int G, c;
    __device__ bool next(int i, Unit& u) const { const int L = i * G + c; if (L >= 256) return false; u.pm = L; u.pn = L >> 6; return true; }
    __device__ __forceinline__ void a_ready(const Unit&) const {}
    __device__ __forceinline__ void done(const Unit&) const {}
};
}

namespace att {
typedef unsigned short bf16;
typedef short bf16x8 __attribute__((ext_vector_type(8)));
typedef short s16x4 __attribute__((ext_vector_type(4)));
typedef float f32x16 __attribute__((ext_vector_type(16)));
typedef float f32x4 __attribute__((ext_vector_type(4)));
typedef unsigned u32x4 __attribute__((ext_vector_type(4)));
constexpr int NW = 8, QBLK = 32, KVBLK = 64, QB = NW * QBLK, NQB = SEQ / QB;
constexpr int SHM_V = KVBLK * DV * 2, SHM_K = KVBLK * DQK * 2;
constexpr int NVB = 3;
constexpr int LDS_BYTES = NVB * SHM_V + 2 * SHM_K + NW * 64 * 4;
constexpr float SCALE = 0.07216878364870322f;
constexpr float THR = 8.f;
constexpr int OPITCH = MLAW;

#define KSWZ(row, colB) ((row) * 384 + ((colB) ^ ((((row) >> 1) & 7) << 4)))
#define SBAR() __builtin_amdgcn_sched_barrier(0)
__device__ __forceinline__ int v_st(int k, int c) { const int kk = (k & ~0xC) | ((k & 4) << 1) | ((k & 8) >> 1); return ((kk >> 3) * 4 + (c >> 5)) * 512 + ((kk & 7) * 32 + (c & 31)) * 2; }
__device__ __forceinline__ int v_rd_base(int lane) { return ((lane & 3) << 3) | (((lane >> 2) & 3) << 6) | (((lane >> 4) & 1) << 5) | (((lane >> 5) & 1) << 8); }
constexpr int v_rd_off(int d0, int ks, int half) { return d0 * 512 + ks * 4096 + half * 2048; }
__device__ __forceinline__ int crow(int r, int hi) { return (r & 3) + 8 * (r >> 2) + 4 * hi; }
__device__ __forceinline__ unsigned cvtpk(float lo, float hi) { return pg8::cvt_pk_bf16(lo, hi); }
__device__ __forceinline__ bf16x8 ld8(const bf16* p) { return *reinterpret_cast<const bf16x8*>(p); }
__device__ __forceinline__ void mask_tile(f32x16& p0, f32x16& p1, int dq) {
    const float NEG = -__builtin_inff();
#pragma unroll
    for (int r = 0; r < 16; ++r) { const int c = (r & 3) + 8 * (r >> 2);
        if (dq - c < 0) p0[r] = NEG;
        if (dq - c - 32 < 0) p1[r] = NEG; }
}
__device__ __forceinline__ void partialSM(f32x16& p0, f32x16& p1, float& m_reg, float& mn, float& alpha) {
    float pmax = p0[0]; for (int r = 1; r < 16; ++r) pmax = fmaxf(pmax, p0[r]); for (int r = 0; r < 16; ++r) pmax = fmaxf(pmax, p1[r]);
    { auto rr = __builtin_amdgcn_permlane32_swap(__float_as_uint(pmax), __float_as_uint(pmax), false, false);
      pmax = fmaxf(__uint_as_float(rr[0]), __uint_as_float(rr[1])); }
    constexpr float C2 = 1.4426950408889634f * SCALE;
    if (__builtin_expect(__all((pmax - m_reg) * SCALE <= THR), 1)) { mn = m_reg; alpha = 1.f; }
    else { mn = fmaxf(m_reg, pmax); alpha = __builtin_amdgcn_exp2f((m_reg - mn) * C2); m_reg = mn; }
    const float mnL = -mn * C2;
    for (int r = 0; r < 16; ++r) p0[r] = fmaf(p0[r], C2, mnL); for (int r = 0; r < 16; ++r) p1[r] = fmaf(p1[r], C2, mnL);
    for (int r = 0; r < 16; ++r) p0[r] = __builtin_amdgcn_exp2f(p0[r]);
}
__device__ __forceinline__ void finishSM(f32x16& p0, f32x16& p1, float alpha, float& l_reg, bf16x8& pa0, bf16x8& pa1, bf16x8& pa2, bf16x8& pa3) {
    for (int r = 0; r < 16; ++r) p1[r] = __builtin_amdgcn_exp2f(p1[r]);
    float ps = 0; for (int r = 0; r < 16; ++r) ps += p0[r]; for (int r = 0; r < 16; ++r) ps += p1[r];
    { auto rr = __builtin_amdgcn_permlane32_swap(__float_as_uint(ps), __float_as_uint(ps), false, false);
      ps = __uint_as_float(rr[0]) + __uint_as_float(rr[1]); }
    l_reg = l_reg * alpha + ps;
#define PK4(P, B_, OUT) do { unsigned a0 = cvtpk(P[B_+0], P[B_+1]), a1 = cvtpk(P[B_+2], P[B_+3]);                          \
        unsigned b0 = cvtpk(P[B_+4], P[B_+5]), b1 = cvtpk(P[B_+6], P[B_+7]);                                             \
        auto r0 = __builtin_amdgcn_permlane32_swap(a0, b0, false, false); auto r1 = __builtin_amdgcn_permlane32_swap(a1, b1, false, false); \
        u32x4 w = {r0[0], r1[0], r0[1], r1[1]}; OUT = *reinterpret_cast<bf16x8*>(&w); } while (0)
    PK4(p0, 0, pa0); PK4(p0, 8, pa1); PK4(p1, 0, pa2); PK4(p1, 8, pa3);
#undef PK4
}
template <int KB>
__device__ __forceinline__ void qkt(f32x16& p0, f32x16& p1, const char* K_lds, int r32, int hi, const bf16x8* qr) {
    p0 = f32x16{}; p1 = f32x16{};
    const char* kb[4];
#pragma unroll
    for (int dd = 0; dd < 4; ++dd) kb[dd] = K_lds + KB * SHM_K + KSWZ(r32, (dd * 16 + hi * 8) * 2);
#pragma unroll
    for (int d0 = 0; d0 < 12; ++d0) { const char* a = kb[d0 & 3] + (d0 >> 2) * 128;
        bf16x8 b0 = *reinterpret_cast<const bf16x8*>(a);
        bf16x8 b1 = *reinterpret_cast<const bf16x8*>(a + 32 * 384);
        p0 = __builtin_amdgcn_mfma_f32_32x32x16_bf16(b0, qr[d0], p0, 0, 0, 0);
        p1 = __builtin_amdgcn_mfma_f32_32x32x16_bf16(b1, qr[d0], p1, 0, 0, 0); }
}
template <int VB>
__device__ __forceinline__ void pv_tile(f32x16* o, int vb0, bf16x8 pa0, bf16x8 pa1, bf16x8 pa2, bf16x8 pa3) {
#define TRRD(dst, off) asm volatile("ds_read_b64_tr_b16 %0, %1 offset:%2" : "=&v"(dst) : "v"(vb0), "i"(off) : "memory")
#define PV_D0(d0) do { s16x4 l0, l1, l2, l3, h0, h1, h2, h3; constexpr int b_ = VB * SHM_V + v_rd_off(d0, 0, 0); \
        TRRD(l0, b_); TRRD(h0, b_ + 2048); TRRD(l1, b_ + 4096); TRRD(h1, b_ + 6144); TRRD(l2, b_ + 8192); TRRD(h2, b_ + 10240); TRRD(l3, b_ + 12288); TRRD(h3, b_ + 14336); \
        asm volatile("s_waitcnt lgkmcnt(0)" ::: "memory"); SBAR();   \
        o[d0] = __builtin_amdgcn_mfma_f32_32x32x16_bf16(pa0, (bf16x8){l0[0], l0[1], l0[2], l0[3], h0[0], h0[1], h0[2], h0[3]}, o[d0], 0, 0, 0);   \
        o[d0] = __builtin_amdgcn_mfma_f32_32x32x16_bf16(pa1, (bf16x8){l1[0], l1[1], l1[2], l1[3], h1[0], h1[1], h1[2], h1[3]}, o[d0], 0, 0, 0);   \
        o[d0] = __builtin_amdgcn_mfma_f32_32x32x16_bf16(pa2, (bf16x8){l2[0], l2[1], l2[2], l2[3], h2[0], h2[1], h2[2], h2[3]}, o[d0], 0, 0, 0);   \
        o[d0] = __builtin_amdgcn_mfma_f32_32x32x16_bf16(pa3, (bf16x8){l3[0], l3[1], l3[2], l3[3], h3[0], h3[1], h3[2], h3[3]}, o[d0], 0, 0, 0); } while (0)
    PV_D0(0); PV_D0(1); PV_D0(2); PV_D0(3);
#undef PV_D0
#undef TRRD
}
#ifndef DRY_NOSM
#define DRY_NOSM 0
#endif
#ifndef DRY_NOSTAGE
#define DRY_NOSTAGE 0
#endif
#ifndef DRY_WRAP
#define DRY_WRAP 0
#endif
__device__ __forceinline__ void cheapSM(f32x16& p0, f32x16& p1, float& l_reg, bf16x8& pa0, bf16x8& pa1, bf16x8& pa2, bf16x8& pa3) {
    l_reg += fabsf(p0[0]) + fabsf(p1[0]);
#define PK4(P, B_, OUT) do { unsigned a0 = cvtpk(P[B_+0], P[B_+1]), a1 = cvtpk(P[B_+2], P[B_+3]);                          \
        unsigned b0 = cvtpk(P[B_+4], P[B_+5]), b1 = cvtpk(P[B_+6], P[B_+7]);                                             \
        auto r0 = __builtin_amdgcn_permlane32_swap(a0, b0, false, false); auto r1 = __builtin_amdgcn_permlane32_swap(a1, b1, false, false); \
        u32x4 w = {r0[0], r1[0], r0[1], r1[1]}; OUT = *reinterpret_cast<bf16x8*>(&w); } while (0)
    PK4(p0, 0, pa0); PK4(p0, 8, pa1); PK4(p1, 0, pa2); PK4(p1, 8, pa3);
#undef PK4
}
struct BlockRef { const bf16* Q; const bf16* Kn; const bf16* Kp; const bf16* V; bf16* O; int P0; };
#define VMW() asm volatile("s_waitcnt vmcnt(0)" ::: "memory")
typedef __attribute__((address_space(3))) unsigned lds_u32;
#define STAGE(kbf, vbf, k0) do {                                                                                                                 \
        _Pragma("unroll") for (int i_ = 0; i_ < 2; ++i_) __builtin_amdgcn_global_load_lds((const unsigned*)(pV[i_] + (size_t)(k0) * (DV * 2)),    \
            (lds_u32*)(uintptr_t)(ldsV + (vbf) * SHM_V + (wid * 2 + i_) * 1024), 16, 0, 0);                                                      \
        _Pragma("unroll") for (int i_ = 0; i_ < 3; ++i_) __builtin_amdgcn_global_load_lds((const unsigned*)(pK[i_] + (size_t)(k0) * stK[i_]),     \
            (lds_u32*)(uintptr_t)(ldsK + (kbf) * SHM_K + (wid * 3 + i_) * 1024), 16, 0, 0); } while (0)
__device__ __forceinline__ void attn_block(const BlockRef& cur, char* lds, bool rev, bool dry = false) {
    int tid_ = threadIdx.x; asm volatile("" : "+v"(tid_));
    const int tid = tid_, wid = __builtin_amdgcn_readfirstlane(tid >> 6), lane = tid & 63, r32 = lane & 31, hi = lane >> 5;
    const int NT = cur.P0 / KVBLK + QB / KVBLK;
    const int qlo = cur.P0 + wid * QBLK, qm = qlo + r32 - 4 * hi;
    char* V_lds = lds; char* K_lds = lds + NVB * SHM_V;
    float* ws = (float*)(lds + NVB * SHM_V + 2 * SHM_K) + wid * 64; float* li_l = ws, * al_l = ws + 32;
    const int vb0 = (int)(uintptr_t)V_lds + v_rd_base(lane);
    const unsigned ldsV = (unsigned)(uintptr_t)V_lds, ldsK = (unsigned)(uintptr_t)K_lds;
    const unsigned lo_q = (unsigned)(r32 * DQK + hi * 8) * 2u, lo_o = (unsigned)(hi * 4 * OPITCH + (r32 & ~1)) * 2u;
    const char* pK[3]; unsigned stK[3]; const char* pV[2];
#pragma unroll
    for (int i = 0; i < 3; ++i) { const int o_ = (wid * 3 + i) * 1024 + lane * 16, r = o_ / 384, s = (o_ % 384) / 16, c = (s & ~7) | ((s ^ (r >> 1)) & 7);
        if (c < 16) { pK[i] = (const char*)cur.Kn + (r * DNOPE + c * 8) * 2; stK[i] = DNOPE * 2; } else { pK[i] = (const char*)cur.Kp + (r * DROPE + (c - 16) * 8) * 2; stK[i] = DROPE * 2; } }
#pragma unroll
    for (int i = 0; i < 2; ++i) { const int o_ = (wid * 2 + i) * 1024 + lane * 16, st = o_ / 512, w2 = (o_ % 512) / 2, kk = (st / 4) * 8 + w2 / 32, c = (st % 4) * 32 + (w2 % 32);
        const int k = (kk & ~0xC) | ((kk & 4) << 1) | ((kk & 8) >> 1); pV[i] = (const char*)cur.V + (k * DV + c) * 2; }
    bf16x8 qr[12];
    { const char* qb_ = (const char*)cur.Q + (size_t)wid * (QBLK * DQK * 2);
#pragma unroll
      for (int d0 = 0; d0 < 12; ++d0) qr[d0] = *(const bf16x8*)(qb_ + lo_q + d0 * 32); }
    const bool grpB = wid >= 4;
#define TILE_KB(t) ((rev ? NT - 1 - (t) : (t)) * KVBLK)
    STAGE(0, 0, TILE_KB(0)); VMW();
    __syncthreads();
    float m_reg = -1e30f, l_reg = 0; f32x16 o[4] = {};
#define RESC(a) do { if (__any((a) < 1.f)) { if (hi == 0) al_l[r32] = (a); asm volatile("s_waitcnt lgkmcnt(0)" ::: "memory");              \
                     for (int d_ = 0; d_ < 4; ++d_) for (int r = 0; r < 16; ++r) o[d_][r] *= al_l[crow(r, hi)]; } } while (0)
#define SM_PV(tt, vslot) do { const int kq_ = TILE_KB(tt);                                                                    \
        if (kq_ + KVBLK - 1 > qlo) mask_tile(p0, p1, qm - kq_);                                                               \
        float mn, al = 1.f; bf16x8 pa0, pa1, pa2, pa3;                                                                         \
        if (DRY_NOSM && dry) { cheapSM(p0, p1, l_reg, pa0, pa1, pa2, pa3); } else { partialSM(p0, p1, m_reg, mn, al); finishSM(p0, p1, al, l_reg, pa0, pa1, pa2, pa3); } \
        RESC(al); SBAR();                                                                                                     \
        pv_tile<0>(o, vb0 + (vslot) * SHM_V, pa0, pa1, pa2, pa3); } while (0)
    if (!grpB) {
        int vs = 0;
        for (int t = 0; t <= NT; ++t) { const int kbuf = t & 1, vn = vs == 2 ? 0 : vs + 1;
            if (t + 1 < NT && !(DRY_NOSTAGE && dry)) STAGE(kbuf ^ 1, vn, TILE_KB(t + 1));
            if (t < NT) { f32x16 p0, p1; SBAR(); qkt<0>(p0, p1, K_lds + kbuf * SHM_K, r32, hi, qr); SM_PV(t, vs); }
            VMW(); __syncthreads();
            vs = vn; }
    } else {
        int vs = 0; f32x16 p0, p1;
        if (!(DRY_NOSTAGE && dry)) STAGE(1, 1, TILE_KB(1));
        SBAR(); qkt<0>(p0, p1, K_lds, r32, hi, qr);
        VMW(); __syncthreads();
        vs = 1;
        for (int t = 1; t <= NT; ++t) { const int kbuf = t & 1, vn = vs == 2 ? 0 : vs + 1, vp = vs == 0 ? 2 : vs - 1;
            if (t + 1 < NT && !(DRY_NOSTAGE && dry)) STAGE(kbuf ^ 1, vn, TILE_KB(t + 1));
            SM_PV(t - 1, vp);
            if (t < NT) { SBAR(); qkt<0>(p0, p1, K_lds + kbuf * SHM_K, r32, hi, qr); }
            VMW(); __syncthreads();
            vs = vn; }
    }
#undef SM_PV
#undef TILE_KB
#undef STEP
#undef RESC
    if (hi == 0) li_l[r32] = l_reg; asm volatile("s_waitcnt lgkmcnt(0)" ::: "memory");
    char* ob_ = (char*)cur.O + (size_t)wid * (QBLK * OPITCH * 2);
    unsigned gw[16][4];
#pragma unroll
    for (int r = 0; r < 16; ++r) { const unsigned* gp = (const unsigned*)(ob_ + (size_t)((r & 3) + 8 * (r >> 2)) * (OPITCH * 2) + lo_o);
#pragma unroll
        for (int d0 = 0; d0 < 4; ++d0) gw[r][d0] = gp[d0 * 16]; }
    asm volatile("" ::: "memory");
#pragma unroll
    for (int r = 0; r < 16; ++r) { const float rli = __builtin_amdgcn_rcpf(li_l[crow(r, hi)]);
        unsigned* gp = (unsigned*)(ob_ + (size_t)((r & 3) + 8 * (r >> 2)) * (OPITCH * 2) + lo_o);
#pragma unroll
        for (int d0 = 0; d0 < 4; ++d0) { const float v = o[d0][r] * rli; const float vn = __shfl_xor(v, 1);
            if ((r32 & 1) == 0 && (!dry || l_reg < 0.f)) gp[d0 * 16] = cvtpk(v * __uint_as_float(gw[r][d0] << 16), vn * __uint_as_float(gw[r][d0] & 0xffff0000u)); } }
    __syncthreads();
}
#undef VMW
#undef STAGE
struct Tensors { const bf16* Q; const bf16* Kn; const bf16* Kp; const bf16* V; bf16* O; };
__device__ __forceinline__ BlockRef mk_ref(const Tensors& T, int L, int pass) {
    const int h = L >> 5, x = L & 31, qb = pass ? x : (NQB - 1 - x); BlockRef r;
    r.Q = T.Q + ((size_t)h * SEQ + (size_t)qb * QB) * DQK; r.Kn = T.Kn + (size_t)h * SEQ * DNOPE; r.Kp = T.Kp; r.V = T.V + (size_t)h * SEQ * DV;
    r.O = T.O + (size_t)qb * QB * OPITCH + h * DV; r.P0 = qb * QB; return r;
}
__device__ __forceinline__ void attn_phase(char* lds, const Tensors& T, int first, int stride, bool dry = false) {
    constexpr int total = NH * (NQB / 2);
    for (int L = first; L < total; L += stride)
        for (int pass = 0; pass < 2; ++pass) { const BlockRef cur = mk_ref(T, L, pass); attn_block(cur, lds, pass != 0, dry); }
}
#undef KSWZ
#undef SBAR
}

constexpr int NWAVES = 8, NTHREADS = NWAVES * 64;
constexpr int LDS_BYTES = 131072 + 1024;
constexpr size_t MiB = 1u << 20;
constexpr size_t WS_MOD = 0;
constexpr size_t WS_WIN = 1 * MiB, WS_WQB = 38 * MiB, WS_WKVB = 41 * MiB, WS_WMLAO = 45 * MiB, WS_WPOOLG = 53 * MiB, WS_WPOOLO = 54 * MiB, WS_WOUT = 58 * MiB;
constexpr size_t WS_R1 = 66 * MiB;
constexpr size_t WS_SGATE = 130 * MiB;
constexpr size_t WS_SPGATE = 194 * MiB;
constexpr size_t WS_GATES = 226 * MiB;
constexpr size_t WS_LAT = 354 * MiB;
constexpr size_t WS_POOLIN = 422 * MiB;
constexpr size_t WS_Q = 354 * MiB;
constexpr size_t WS_PMIX = 450 * MiB;
constexpr size_t WS_KVN = 486 * MiB;
constexpr size_t WS_CS = 502 * MiB;
constexpr size_t WS_END = 506 * MiB;
constexpr size_t DO_KN = 0, DO_KP = 64 * MiB, DO_POOLED = 66 * MiB, DO_QN = 98 * MiB;
static_assert(WS_LAT + (size_t)SEQ * LATW * 4 <= WS_POOLIN && WS_Q + (size_t)NH * SEQ * DQK * 2 <= WS_PMIX && WS_PMIX + (size_t)SEQ * POOLW * 2 <= WS_KVN && WS_CS + (size_t)SEQ * 64 * 4 <= WS_END, "ws map");
static_assert(WS_WIN + (size_t)INW_PAD * DM * 2 <= WS_WQB && WS_WOUT + (size_t)DM * DM * 2 <= WS_R1 && DO_QN + (size_t)SEQ * QLR * 2 <= 128 * MiB, "ws map 2");

#define LAS __attribute__((address_space(3)))
typedef unsigned short bf16_t;
typedef float f32x4 __attribute__((ext_vector_type(4)));
typedef unsigned u32x4 __attribute__((ext_vector_type(4)));
typedef unsigned u32x2 __attribute__((ext_vector_type(2)));
__device__ __forceinline__ unsigned pk2(float lo, float hi) { return pg8::cvt_pk_bf16(lo, hi); }
__device__ __forceinline__ float wave_sum(float v) {
#pragma unroll
    for (int o = 1; o < 64; o <<= 1) v += __shfl_xor(v, o);
    return v;
}
__device__ __forceinline__ int ropeperm(int j) { const int blk = j >> 3, w = j & 7; return (w < 4) ? 4 * blk + w : 32 + 4 * blk + (w - 4); }
template <int MAP> __device__ __forceinline__ int src_col(int r) {
    if (MAP == 1) { if (r < 1024) return r; if (r < 1088) return 1024 + ropeperm(r - 1024); if (r < 1280) return -1; return r - 192; }
    if (MAP == 2) { if (r < 2048) return (r >> 7) * DQK + (r & 127); const int q = r - 2048; return (q >> 6) * DQK + DNOPE + ropeperm(q & 63); }
    if (MAP == 3) { if (r < 2048) return (r >> 7) * 256 + (r & 127); const int q = r - 2048; return (q >> 7) * 256 + 128 + (q & 127); }
    return r;
}
template <int MAP> __device__ __forceinline__ void transpose_item(const float* W, int K, int Nsrc, int Ndst, bf16_t* WT, LAS float* scr, int item, int lane) {
    const int nblk = Ndst / 32, kb = item / nblk, nb = item % nblk, k0 = 64 * kb, n0 = 32 * nb;
    const int sc = src_col<MAP>(n0 + (lane & 31));
    float tv_[32];
#pragma unroll
    for (int i = 0; i < 32; ++i) { const int kk = 2 * i + (lane >> 5); tv_[i] = sc >= 0 ? W[(size_t)(k0 + kk) * Nsrc + sc] : 0.f; }
#pragma unroll
    for (int i = 0; i < 32; ++i) { const int kk = 2 * i + (lane >> 5); scr[kk * 33 + (lane & 31)] = tv_[i]; }
    asm volatile("s_waitcnt lgkmcnt(0)" ::: "memory");
    const int c = lane & 7;
#pragma unroll
    for (int j = 0; j < 4; ++j) { const int n = (lane >> 3) + 8 * j; const LAS float* s = scr + (8 * c) * 33 + n;
        u32x4 o; o.x = pk2(s[0 * 33], s[1 * 33]); o.y = pk2(s[2 * 33], s[3 * 33]); o.z = pk2(s[4 * 33], s[5 * 33]); o.w = pk2(s[6 * 33], s[7 * 33]);
        *(u32x4*)(WT + (size_t)(n0 + n) * K + k0 + 8 * c) = o; }
    asm volatile("s_waitcnt lgkmcnt(0)" ::: "memory");
}

#define XB_TMO      128
#define XB_XCNT(j)  (256  + 64 * (j))
#define XB_XSUB(j)  (1280 + 64 * (j))
#define XB_XGEN(j)  (2304 + 64 * (j))
#define XB_TOP      3328
#define XB_TOPGEN   3392
#define XCD_BAR_WORDS 3456
#define XB_SPIN_CAP (1u << 18)

__device__ __forceinline__ unsigned xb_ld(unsigned* p)              { return __hip_atomic_load(p, __ATOMIC_RELAXED, __HIP_MEMORY_SCOPE_AGENT); }
__device__ __forceinline__ unsigned xb_add(unsigned* p, unsigned v) { return __hip_atomic_fetch_add(p, v, __ATOMIC_RELAXED, __HIP_MEMORY_SCOPE_AGENT); }
__device__ __forceinline__ unsigned xb_xcc_id() { return (unsigned)__builtin_amdgcn_s_getreg((3 << 11) | 20) & 0xFu; }
#define XB_SPIN(cond, bar) do { unsigned _sp = 0; while (cond) { __builtin_amdgcn_s_sleep(1); \
    if ((++_sp & 255u) == 0u) { if (xb_ld(&(bar)[XB_TMO])) break; if (_sp > XB_SPIN_CAP) { atomicAdd(&(bar)[XB_TMO], 1u); break; } } } } while (0)

struct XcdBarrier {
    unsigned* bar; unsigned x;
    volatile LAS unsigned* st;
};

__device__ __forceinline__ XcdBarrier xcd_barrier_post(unsigned* bar, volatile LAS unsigned* st) {
    XcdBarrier b; b.bar = bar; b.x = xb_xcc_id(); b.st = st;
    if (threadIdx.x == 0) (void)xb_add(&bar[XB_XCNT(b.x)], 1u);
    return b;
}
__device__ __forceinline__ void xcd_barrier_complete(unsigned* bar, unsigned x, unsigned& nloc, unsigned& nx) {
    const unsigned G = gridDim.x * gridDim.y * gridDim.z;
    unsigned sum, cnt, mine, sp = 0u;
    for (;;) {
        sum = 0u; cnt = 0u; mine = 0u;
#pragma unroll
        for (unsigned j = 0; j < 16; ++j) { const unsigned c = xb_ld(&bar[XB_XCNT(j)]); sum += c; cnt += (c > 0u) ? 1u : 0u; mine = (j == x) ? c : mine; }
        if (sum == G) break;
        __builtin_amdgcn_s_sleep(1);
        if ((++sp & 255u) == 0u) { if (xb_ld(&bar[XB_TMO])) break; if (sp > XB_SPIN_CAP) { atomicAdd(&bar[XB_TMO], 1u); break; } }
    }
    nloc = mine > 0u ? mine : 1u; nx = cnt > 0u ? cnt : 1u;
}

__device__ __forceinline__ void xcd_barrier(const XcdBarrier& b) {
    asm volatile("s_waitcnt vmcnt(0)" ::: "memory");
    __syncthreads();
    if (threadIdx.x == 0) {
        unsigned* bar = b.bar;
        __builtin_amdgcn_s_waitcnt(0);
        unsigned nloc = b.st[0], nx = b.st[1];
        if (nloc == 0u) { xcd_barrier_complete(bar, b.x, nloc, nx); b.st[0] = nloc; b.st[1] = nx; }
        const unsigned old = xb_add(&bar[XB_XSUB(b.x)], 1u);
        const unsigned gen = old / nloc;
        if (old + 1u == (gen + 1u) * nloc) {
            __builtin_amdgcn_fence(__ATOMIC_RELEASE, "agent");
            asm volatile("s_waitcnt vmcnt(0)" ::: "memory");
            const unsigned og = xb_add(&bar[XB_TOP], 1u);
            const unsigned tg = og / nx;
            if (og + 1u == (tg + 1u) * nx) xb_add(&bar[XB_TOPGEN], 1u);
            else XB_SPIN(xb_ld(&bar[XB_TOPGEN]) == tg, bar);
            __builtin_amdgcn_fence(__ATOMIC_ACQUIRE, "agent");
            xb_add(&bar[XB_XGEN(b.x)], 1u);
            asm volatile("s_waitcnt vmcnt(0)" ::: "memory");
        } else {
            XB_SPIN(xb_ld(&bar[XB_XGEN(b.x)]) == gen, bar);
            __builtin_amdgcn_fence(__ATOMIC_ACQUIRE, "agent");
            asm volatile("s_waitcnt vmcnt(0)" ::: "memory");
        }
    }
    __syncthreads();
}

constexpr size_t WS_BAR = 64 * 1024;
#define GRID_SYNC() do { asm volatile("s_waitcnt vmcnt(0) lgkmcnt(0)" ::: "memory"); grid.sync(); } while (0)
struct Args { const void* in[18]; float* out; unsigned char* ws; };
__global__ void __launch_bounds__(NTHREADS) mk_fwd(Args a) {
    extern __shared__ __attribute__((aligned(16))) unsigned char lds[];
    cg::grid_group grid = cg::this_grid();
    const int tid = threadIdx.x, lane = tid & 63, wave = __builtin_amdgcn_readfirstlane(tid >> 6);
    const int G = gridDim.x, bx = blockIdx.x, vcu = (G % 8 == 0) ? (bx % 8) * (G / 8) + bx / 8 : bx;
    const int gw = vcu * NWAVES + wave, NGW = G * NWAVES;
    unsigned char* ws = a.ws; unsigned char* dob = (unsigned char*)a.out;
    const float* x = (const float*)a.in[0]; const float* cvec = (const float*)a.in[1]; const int* positions = (const int*)a.in[2];
    const float* w_ada = (const float*)a.in[3]; const float* b_ada = (const float*)a.in[4]; const float* w_in = (const float*)a.in[5];
    const float* b_gates = (const float*)a.in[6]; const float* q_norm_g = (const float*)a.in[7]; const float* w_q_b = (const float*)a.in[8];
    const float* kv_norm_g = (const float*)a.in[9]; const float* w_kv_b = (const float*)a.in[10]; const float* w_mla_o = (const float*)a.in[11];
    const float* w_pool_g = (const float*)a.in[12]; const float* pool_scale = (const float*)a.in[13]; const float* w_pool_o = (const float*)a.in[14];
    const float* w_out = (const float*)a.in[15]; const float* ln_g = (const float*)a.in[16]; const float* ln_b = (const float*)a.in[17];
    float* modv = (float*)(ws + WS_MOD);
    bf16_t* Wt_in = (bf16_t*)(ws + WS_WIN); bf16_t* Wt_qb = (bf16_t*)(ws + WS_WQB); bf16_t* Wt_kvb = (bf16_t*)(ws + WS_WKVB); bf16_t* Wt_mlao = (bf16_t*)(ws + WS_WMLAO);
    bf16_t* Wt_poolg = (bf16_t*)(ws + WS_WPOOLG); bf16_t* Wt_poolo = (bf16_t*)(ws + WS_WPOOLO); bf16_t* Wt_out = (bf16_t*)(ws + WS_WOUT);
    bf16_t* hbuf = (bf16_t*)(ws + WS_R1); bf16_t* Vb = (bf16_t*)(ws + WS_R1); bf16_t* zb = (bf16_t*)(ws + WS_R1);
    bf16_t* sgate = (bf16_t*)(ws + WS_SGATE); bf16_t* spgate = (bf16_t*)(ws + WS_SPGATE); bf16_t* gates = (bf16_t*)(ws + WS_GATES);
    float* lat = (float*)(ws + WS_LAT); float* pool_in = (float*)(ws + WS_POOLIN); bf16_t* Qb = (bf16_t*)(ws + WS_Q); bf16_t* pmix = (bf16_t*)(ws + WS_PMIX);
    bf16_t* kvn = (bf16_t*)(ws + WS_KVN); float* cs = (float*)(ws + WS_CS);
    bf16_t* Kn = (bf16_t*)(dob + DO_KN); bf16_t* Kp = (bf16_t*)(dob + DO_KP); bf16_t* pooled = (bf16_t*)(dob + DO_POOLED); bf16_t* qn = (bf16_t*)(dob + DO_QN);
    LAS unsigned char* ldsl = (LAS unsigned char*)lds;
    volatile LAS unsigned* bar_st = (volatile LAS unsigned*)(ldsl + 131072);
    if (tid < 2) bar_st[tid] = 0u;
    if (bx == 0) for (int u_ = tid; u_ < XCD_BAR_WORDS; u_ += NTHREADS) ((unsigned*)(ws + WS_BAR))[u_] = 0u;
    __syncthreads();


    for (int cb = bx; cb < 192; cb += G) {
        LAS f32x4* red = (LAS f32x4*)lds;
        const int c4 = tid & 7, rg = tid >> 3; f32x4 acc = {0.f, 0.f, 0.f, 0.f};
        const float* wp = w_ada + 32 * cb + 4 * c4;
#pragma unroll 8
        for (int d = rg; d < DM; d += 64) { const float cv = cvec[d]; const float sv = cv * pg8::sigmoid_f(cv); acc += *(const f32x4*)(wp + (size_t)d * (3 * DM)) * sv; }
        red[rg * 8 + c4] = acc;
        __syncthreads();
        if (tid < 32) { const LAS float* rf = (const LAS float*)lds; float s = 0.f;
            for (int r = 0; r < 64; ++r) s += rf[r * 32 + tid];
            modv[32 * cb + tid] = s + b_ada[32 * cb + tid]; }
        __syncthreads();
    }
    for (int e = bx * NTHREADS + tid; e < SEQ * 32; e += G * NTHREADS) {
        const int s = e >> 5, i = e & 31; const float inv_freq = exp2f(-(float)i * (13.287712379549449f / 32.f));
        const float ang = (float)positions[s] * inv_freq; float sn, cn; sincosf(ang, &sn, &cn);
        cs[2 * e] = cn; cs[2 * e + 1] = sn;
    }
    {
        LAS float* scr = (LAS float*)(ldsl + wave * 16384);
        constexpr int I_IN = (DM / 64) * (INW_PAD / 32);
        for (int it = gw; it < I_IN; it += NGW) transpose_item<1>(w_in, DM, INW, INW_PAD, Wt_in, scr, it, lane);
    }
    GRID_SYNC();
    const XcdBarrier xbar = xcd_barrier_post((unsigned*)(ws + WS_BAR), bar_st);

    for (int row = gw; row < SEQ; row += NGW) {
        const f32x4* xr = (const f32x4*)(x + (size_t)row * DM) + lane;
        f32x4 v[8]; float s = 0.f;
#pragma unroll
        for (int j = 0; j < 8; ++j) { v[j] = xr[64 * j]; s += (v[j][0] + v[j][1]) + (v[j][2] + v[j][3]); }
        const float mean = wave_sum(s) * (1.f / DM); float s2 = 0.f;
#pragma unroll
        for (int j = 0; j < 8; ++j) { v[j] = v[j] - mean; s2 += (v[j][0] * v[j][0] + v[j][1] * v[j][1]) + (v[j][2] * v[j][2] + v[j][3] * v[j][3]); }
        const float rstd = 1.f / sqrtf(wave_sum(s2) * (1.f / DM) + LN_EPS);
        u32x2* o8 = (u32x2*)(hbuf + (size_t)row * DM) + lane;
#pragma unroll
        for (int j = 0; j < 8; ++j) { const f32x4 sh = *((const f32x4*)modv + lane + 64 * j), sc = *((const f32x4*)(modv + DM) + lane + 64 * j);
            const f32x4 y = v[j] * rstd * (sc + 1.f) + sh; u32x2 w; w.x = pk2(y[0], y[1]); w.y = pk2(y[2], y[3]); o8[64 * j] = w; }
    }
    xcd_barrier(xbar);

    {
        pg8::Gemm g{hbuf, Wt_in, SEQ, INW_PAD, DM}; pg8::StaticOrder S; S.init(SEQ, INW_PAD, G, bx);
        pg8::EpiIn E{lat, sgate, pool_in, spgate, gates, b_gates};
        pg8::gemm_phase<pg8::EpiIn, pg8::StaticOrder, true, true>(ldsl, g, S, E);
    }
    if (bx >= 64 || G != 256) {
        LAS float* scr = (LAS float*)(ldsl + wave * 16384);
        constexpr int I_QB = (QLR / 64) * (3072 / 32), I_KVB = (KVLR / 64) * (4096 / 32), I_MLAO = (MLAW / 64) * (DM / 32),
                      I_PG = (256 / 64) * (256 / 32), I_PO = (POOLW / 64) * (DM / 32), I_OUT = (DM / 64) * (DM / 32);
        constexpr int NITEMS = I_QB + I_KVB + I_MLAO + 4 * I_PG + I_PO + I_OUT;
        const int w0 = (G == 256 ? (bx - 64) : bx) * NWAVES + wave, nw = (G == 256 ? (G - 64) : G) * NWAVES;
        for (int it = w0; it < NITEMS; it += nw) {
            int r = it;
            if (r < I_QB) { transpose_item<2>(w_q_b, QLR, 3072, 3072, Wt_qb, scr, r, lane); continue; } r -= I_QB;
            if (r < I_KVB) { transpose_item<3>(w_kv_b, KVLR, 4096, 4096, Wt_kvb, scr, r, lane); continue; } r -= I_KVB;
            if (r < I_MLAO) { transpose_item<0>(w_mla_o, MLAW, DM, DM, Wt_mlao, scr, r, lane); continue; } r -= I_MLAO;
            if (r < 4 * I_PG) { const int g = r / I_PG; transpose_item<0>(w_pool_g + (size_t)g * 65536, 256, 256, 256, Wt_poolg + (size_t)g * 65536, scr, r % I_PG, lane); continue; } r -= 4 * I_PG;
            if (r < I_PO) { transpose_item<0>(w_pool_o, POOLW, DM, DM, Wt_poolo, scr, r, lane); continue; } r -= I_PO;
            transpose_item<0>(w_out, DM, DM, DM, Wt_out, scr, r, lane);
        }
    }
    xcd_barrier(xbar);

    for (int row = gw; row < SEQ; row += NGW) {
        const float* lr = lat + (size_t)row * LATW;
#pragma unroll
        for (int part = 0; part < 2; ++part) {
            const f32x4* p = (const f32x4*)(lr + part * 512) + lane; const f32x4 a0 = p[0], a1 = p[64];
            const float ss = wave_sum((a0[0] * a0[0] + a0[1] * a0[1]) + (a0[2] * a0[2] + a0[3] * a0[3]) + (a1[0] * a1[0] + a1[1] * a1[1]) + (a1[2] * a1[2] + a1[3] * a1[3]));
            const float r = 1.f / sqrtf(ss * (1.f / 512.f) + RMS_EPS);
            const f32x4* gp = (const f32x4*)(part ? kv_norm_g : q_norm_g) + lane; const f32x4 g0 = gp[0], g1 = gp[64];
            u32x2* o = (u32x2*)((part ? kvn : qn) + (size_t)row * 512) + lane;
            const f32x4 y0 = a0 * r * g0, y1 = a1 * r * g1; u32x2 w0, w1; w0.x = pk2(y0[0], y0[1]); w0.y = pk2(y0[2], y0[3]); w1.x = pk2(y1[0], y1[1]); w1.y = pk2(y1[2], y1[3]);
            o[0] = w0; o[64] = w1;
        }
        if (lane < 32) { const int blk = lane >> 2, w = lane & 3; const float x1 = lr[1024 + 8 * blk + w], x2 = lr[1024 + 8 * blk + 4 + w];
            const float cn = cs[(size_t)row * 64 + 2 * lane], sn = cs[(size_t)row * 64 + 2 * lane + 1];
            bf16_t* kp = Kp + (size_t)row * DROPE + 8 * blk + w;
            kp[0] = (bf16_t)(pk2(x1 * cn - x2 * sn, 0.f) & 0xffffu); kp[4] = (bf16_t)(pk2(x1 * sn + x2 * cn, 0.f) & 0xffffu); }
#pragma unroll
        for (int g = 0; g < 4; ++g) {
            const int wlen = 2 << g, cnt = (row + 1 < wlen) ? row + 1 : wlen;
            const f32x4* up = (const f32x4*)(pool_in + (size_t)row * POOLW + 256 * g) + lane; const f32x4 u0 = *up; f32x4 sum = u0;
            for (int j = 1; j < cnt; ++j) sum += *(up - (size_t)j * (POOLW / 4));
            const f32x4 pv = sum * (1.f / (float)cnt) - u0; u32x2 w; w.x = pk2(pv[0], pv[1]); w.y = pk2(pv[2], pv[3]);
            *((u32x2*)(pooled + ((size_t)g * SEQ + row) * 256) + lane) = w;
        }
    }
    xcd_barrier(xbar);

    {
        pg8::Gemm g{qn, Wt_qb, SEQ, 3072, QLR}; pg8::StaticOrder S; S.init(SEQ, 3072, G, bx);
        pg8::EpiQ E{Qb, cs};
        pg8::gemm_phase<pg8::EpiQ, pg8::StaticOrder, true, true>(ldsl, g, S, E);
    }
    {
        pg8::Gemm g{kvn, Wt_kvb, SEQ, 4096, KVLR}; pg8::StaticOrder S; S.init(SEQ, 4096, G, bx);
        pg8::EpiKV E{Kn, Vb};
        pg8::gemm_phase<pg8::EpiKV, pg8::StaticOrder, true, true>(ldsl, g, S, E);
    }
    {
        int kpool = 256; asm volatile("" : "+s"(kpool));
        pg8::Gemm g{pooled, Wt_poolg, 4 * SEQ, 256, kpool}; pg8::PoolOrder S{G, bx};
        pg8::EpiPool E{pmix, spgate, pool_scale};
        pg8::gemm_phase<pg8::EpiPool, pg8::PoolOrder, true, true>(ldsl, g, S, E);
    }
    xcd_barrier(xbar);

    {
        const att::Tensors T{Qb, Kn, Kp, Vb, sgate};
        att::attn_phase((char*)lds, T, vcu, G);
    }
    xcd_barrier(xbar);

    {
    {
        pg8::Gemm g{sgate, Wt_mlao, SEQ, DM, MLAW}; pg8::StaticOrder S; S.init(SEQ, DM, G, bx);
        pg8::EpiMlaO E{zb, gates};
        pg8::gemm_phase<pg8::EpiMlaO, pg8::StaticOrder, true, true>(ldsl, g, S, E);
    }
    {
        pg8::Gemm g{pmix, Wt_poolo, SEQ, DM, POOLW}; pg8::StaticOrder S; S.init(SEQ, DM, G, bx);
        pg8::EpiPoolO E{zb, gates};
        pg8::gemm_phase<pg8::EpiPoolO, pg8::StaticOrder, true, true>(ldsl, g, S, E);
    }
    }
    xcd_barrier(xbar);

    {
        pg8::Gemm g{zb, Wt_out, SEQ, DM, DM}; pg8::StaticOrder S; S.init(SEQ, DM, G, bx);
        pg8::EpiOut E{a.out, x, modv};
        pg8::gemm_phase<pg8::EpiOut, pg8::StaticOrder, true, true>(ldsl, g, S, E);
    }
    xcd_barrier(xbar);

    for (int row = gw; row < SEQ; row += NGW) {
        f32x4* xr = (f32x4*)(a.out + (size_t)row * DM) + lane;
        f32x4 v[8]; float s = 0.f;
#pragma unroll
        for (int j = 0; j < 8; ++j) { v[j] = xr[64 * j]; s += (v[j][0] + v[j][1]) + (v[j][2] + v[j][3]); }
        const float mean = wave_sum(s) * (1.f / DM); float s2 = 0.f;
#pragma unroll
        for (int j = 0; j < 8; ++j) { v[j] = v[j] - mean; s2 += (v[j][0] * v[j][0] + v[j][1] * v[j][1]) + (v[j][2] * v[j][2] + v[j][3] * v[j][3]); }
        const float rstd = 1.f / sqrtf(wave_sum(s2) * (1.f / DM) + LN_EPS);
#pragma unroll
        for (int j = 0; j < 8; ++j) { const f32x4 gg = *((const f32x4*)ln_g + lane + 64 * j), bb = *((const f32x4*)ln_b + lane + 64 * j);
            xr[64 * j] = v[j] * rstd * gg + bb; }

    }
}

extern "C" void kernel_launch(void* const* d_in, const int* in_sizes, int n_in, void* d_out, int out_size, void* d_ws, size_t ws_size, hipStream_t stream) {
    static int grid_blocks = 0;
    if (grid_blocks == 0) {
        if (n_in != 18 || out_size != SEQ * DM || ws_size < WS_END) { fprintf(stderr, "kernel_launch: unexpected shapes (n_in %d out %d ws %zu)\n", n_in, out_size, ws_size); grid_blocks = -1; return; }
        int dev = 0, cus = 0, per_cu = 0;
        (void)hipGetDevice(&dev); (void)hipDeviceGetAttribute(&cus, hipDeviceAttributeMultiprocessorCount, dev);
        if (hipFuncSetAttribute((const void*)mk_fwd, hipFuncAttributeMaxDynamicSharedMemorySize, LDS_BYTES) != hipSuccess) { fprintf(stderr, "kernel_launch: hipFuncSetAttribute failed\n"); grid_blocks = -1; return; }
        if (hipOccupancyMaxActiveBlocksPerMultiprocessor(&per_cu, (const void*)mk_fwd, NTHREADS, LDS_BYTES) != hipSuccess || per_cu < 1) per_cu = 1;
        (void)hipGetLastError();
        grid_blocks = cus * per_cu;
    }
    if (grid_blocks < 0) return;
    Args a{};
    for (int i = 0; i < 18; ++i) a.in[i] = d_in[i];
    a.out = (float*)d_out; a.ws = (unsigned char*)d_ws;
    void* args[] = {&a};
    hipError_t e = hipLaunchCooperativeKernel((const void*)mk_fwd, dim3(grid_blocks), dim3(NTHREADS), args, LDS_BYTES, stream);
    if (e != hipSuccess) fprintf(stderr, "cooperative launch failed: %s (grid %d)\n", hipGetErrorString(e), grid_blocks);
}
```
